# Optimizing an MI355X kernel written in HIP

```python
import math
import jax
import jax.numpy as jnp
from jax import lax
import numpy as np

D_MODEL = 1024
BATCH = 2
SEQ = 8192
DEPTH = 4
DEC_BATCH = 32
DEC_SEQ = 64
PAST_LEN = 4096

CHUNK = 64
N_MIXERS = 4
EPS = 1e-6
D_FF = 2816
GLA_HEADS = 4
GLA_DK = D_MODEL // 2 // GLA_HEADS
GLA_DV = D_MODEL // GLA_HEADS
GLA_RANK = 16
GLA_TAU = 16.0
BAND_HEADS = 16
BAND_DH = D_MODEL // BAND_HEADS
LEFT_CHUNKS = 8
BAND_WINDOW = LEFT_CHUNKS * CHUNK
REL_CLIP = 256
GDN_HEADS = 8
GDN_DK = D_MODEL // GDN_HEADS
GDN_DV = D_MODEL // GDN_HEADS
CONV_W = 4
GDN_CONV_CH = 2 * GDN_HEADS * GDN_DK + GDN_HEADS * GDN_DV
SB_HEADS = 16
SB_DH = D_MODEL // SB_HEADS
SB_QBLOCK = 128

kernel_name = 'hybrid_streaming_encoder_step'


def _count(m):
    return len(range(m, DEPTH, N_MIXERS))


def _chunk_len(L):
    c = min(CHUNK, L)
    assert L % c == 0, 'length must be a multiple of CHUNK or one partial chunk'
    return c


def _to_chunks(t, c):
    B, L = t.shape[:2]
    t = t.astype(jnp.float32).reshape((B, L // c, c) + t.shape[2:])
    return jnp.swapaxes(jnp.moveaxis(t, 1, 0), 2, 3)


def _from_chunks(o):
    nc, B, H, c, d = o.shape
    return jnp.moveaxis(jnp.swapaxes(o, 2, 3), 0, 1).reshape(B, nc * c, H, d)


def rms_norm(x, g):
    xf = x.astype(jnp.float32)
    y = xf * lax.rsqrt(jnp.mean(xf * xf, axis=-1, keepdims=True) + EPS)
    return (y * g.astype(jnp.float32)).astype(x.dtype)


def l2_normalize(x):
    xf = x.astype(jnp.float32)
    return xf * lax.rsqrt(jnp.sum(xf * xf, axis=-1, keepdims=True) + EPS)


def swiglu_ffn(x, w_gu, w_down):
    g, u = jnp.split(x @ w_gu, 2, axis=-1)
    return (jax.nn.silu(g) * u) @ w_down


def gla_chunked(q, k, v, log_a, s0):
    c = _chunk_len(q.shape[1])
    q, k, v, log_a = (_to_chunks(t, c) for t in (q, k, v, log_a))
    b = jnp.cumsum(log_a, axis=3)
    b_last = b[:, :, :, -1:]
    q_e = q * jnp.exp(b)
    k_e = k * jnp.exp(-b)
    k_l = k * jnp.exp(b_last - b)
    incl = jnp.tril(jnp.ones((c, c), bool))
    att = jnp.where(incl, jnp.einsum('nbhik,nbhjk->nbhij', q_e, k_e), 0.0)
    o_intra = jnp.einsum('nbhij,nbhjv->nbhiv', att, v)
    u = jnp.einsum('nbhjk,nbhjv->nbhkv', k_l, v)
    d_last = jnp.exp(b_last[:, :, :, 0])

    def step(s, inp):
        dl, uc = inp
        return dl[..., None] * s + uc, s

    s_fin, s_prev = lax.scan(step, s0.astype(jnp.float32), (d_last, u))
    o = o_intra + jnp.einsum('nbhik,nbhkv->nbhiv', q_e, s_prev)
    return _from_chunks(o), s_fin


def gla_mixer(h, s0, w_in, w_gate2, b_gate, onorm, w_out):
    B, L, _ = h.shape
    qk, vv = GLA_HEADS * GLA_DK, GLA_HEADS * GLA_DV
    q, k, v, r, g_low = jnp.split(h @ w_in, [qk, 2 * qk, 2 * qk + vv, 2 * qk + 2 * vv], axis=-1)
    log_a = jax.nn.log_sigmoid((g_low @ w_gate2 + b_gate).astype(jnp.float32)) / GLA_TAU
    hd = lambda t, d: t.reshape(B, L, GLA_HEADS, d)
    o, s_fin = gla_chunked(hd(q, GLA_DK) * GLA_DK ** -0.5, hd(k, GLA_DK), hd(v, GLA_DV), hd(log_a, GLA_DK), s0)
    o = rms_norm(o, onorm).reshape(B, L, vv).astype(h.dtype) * jax.nn.silu(r)
    return o @ w_out, s_fin


def band_project(h, w_in, q_norm, k_norm):
    B, L, _ = h.shape
    q, k, v = jnp.split(h @ w_in, 3, axis=-1)
    shp = (B, L, BAND_HEADS, BAND_DH)
    return rms_norm(q.reshape(shp), q_norm), rms_norm(k.reshape(shp), k_norm), v.reshape(shp)


def band_attend(q, k, v, q_pos, k_pos, rel_bias):
    s = jnp.einsum('bqhd,bkhd->bhqk', q.astype(jnp.float32), k.astype(jnp.float32)) * BAND_DH ** -0.5
    rel = jnp.clip(q_pos[:, None] - k_pos[None, :], -REL_CLIP, REL_CLIP) + REL_CLIP
    s = s + rel_bias[:, rel].astype(jnp.float32)[None]
    qc, kc = q_pos // CHUNK, k_pos // CHUNK
    visible = (k_pos[None, :] >= 0) & (kc[None, :] <= qc[:, None]) & (kc[None, :] >= qc[:, None] - LEFT_CHUNKS)
    p = jax.nn.softmax(jnp.where(visible[None, None], s, -jnp.inf), axis=-1)
    return jnp.einsum('bhqk,bkhd->bqhd', p, v.astype(jnp.float32))


def band_prompt(h, w_in, q_norm, k_norm, rel_bias, w_out):
    B, L, _ = h.shape
    q, k, v = band_project(h, w_in, q_norm, k_norm)
    span = BAND_WINDOW + CHUNK
    pad = ((0, 0), (BAND_WINDOW, 0), (0, 0), (0, 0))
    kp, vp = jnp.pad(k, pad), jnp.pad(v, pad)

    def one_chunk(c):
        start = c * CHUNK
        qc = lax.dynamic_slice_in_dim(q, start, CHUNK, axis=1)
        kc = lax.dynamic_slice_in_dim(kp, start, span, axis=1)
        vc = lax.dynamic_slice_in_dim(vp, start, span, axis=1)
        return band_attend(qc, kc, vc, start + jnp.arange(CHUNK), start - BAND_WINDOW + jnp.arange(span), rel_bias)

    o = lax.map(one_chunk, jnp.arange(L // CHUNK))
    o = jnp.moveaxis(o, 0, 1).reshape(B, L, D_MODEL).astype(h.dtype)
    keep = min(BAND_WINDOW, L)
    return o @ w_out, k[:, L - keep:], v[:, L - keep:]


def band_sample(h, cache_k, cache_v, past, w_in, q_norm, k_norm, rel_bias, w_out):
    B, L, _ = h.shape
    q, k, v = band_project(h, w_in, q_norm, k_norm)
    wc = cache_k.shape[1]
    kk = jnp.concatenate([cache_k.astype(k.dtype), k], axis=1)
    vv = jnp.concatenate([cache_v.astype(v.dtype), v], axis=1)
    k_pos = jnp.concatenate([past - wc + jnp.arange(wc), past + jnp.arange(L)])
    o = band_attend(q, kk, vv, past + jnp.arange(L), k_pos, rel_bias)
    o = o.reshape(B, L, D_MODEL).astype(h.dtype)
    return o @ w_out, k, v


def causal_conv(x, conv_state, w):
    L = x.shape[1]
    xp = jnp.concatenate([conv_state.astype(x.dtype), x], axis=1)
    y = sum(xp[:, i:i + L] * w[i] for i in range(CONV_W))
    return jax.nn.silu(y), xp[:, L:]


def gated_delta_chunked(q, k, v, g, beta, s0):
    c = _chunk_len(q.shape[1])
    q, k, v = (_to_chunks(t, c) for t in (q, k, v))
    g, beta = (_to_chunks(t, c) for t in (g, beta))
    q = q * (q.shape[-1] ** -0.5)
    gc = jnp.cumsum(g, axis=-1)
    incl = jnp.tril(jnp.ones((c, c), bool))
    strict = jnp.tril(jnp.ones((c, c), bool), -1)
    gam = jnp.exp(jnp.where(incl, gc[..., :, None] - gc[..., None, :], -jnp.inf))
    kb = k * beta[..., None]
    m = jnp.where(strict, jnp.einsum('nbhik,nbhjk->nbhij', kb, k) * gam, 0.0)
    eye = jnp.eye(c, dtype=jnp.float32)
    t_inv = lax.linalg.triangular_solve(eye + m, jnp.broadcast_to(eye, m.shape), left_side=True, lower=True)
    u = jnp.einsum('nbhij,nbhjv->nbhiv', t_inv, v * beta[..., None])
    w = jnp.einsum('nbhij,nbhjk->nbhik', t_inv, kb * jnp.exp(gc)[..., None])
    att = jnp.einsum('nbhik,nbhjk->nbhij', q, k) * gam
    q_e = q * jnp.exp(gc)[..., None]
    k_l = k * jnp.exp(gc[..., -1:] - gc)[..., None]
    d_last = jnp.exp(gc[..., -1])

    def step(s, inp):
        qe, wc, uc, ac, kl, dl = inp
        v_new = uc - jnp.einsum('bhik,bhkv->bhiv', wc, s)
        o = jnp.einsum('bhik,bhkv->bhiv', qe, s) + jnp.einsum('bhij,bhjv->bhiv', ac, v_new)
        s = s * dl[..., None, None] + jnp.einsum('bhjk,bhjv->bhkv', kl, v_new)
        return s, o

    s_fin, o = lax.scan(step, s0.astype(jnp.float32), (q_e, w, u, att, k_l, d_last))
    return _from_chunks(o), s_fin


def gdn_mixer(h, conv_state, s0, w_in, conv_w, a_log, dt_bias, onorm, w_out):
    B, L, _ = h.shape
    qk, vv = GDN_HEADS * GDN_DK, GDN_HEADS * GDN_DV
    qkv, gate, b_raw, a_raw = jnp.split(h @ w_in, [GDN_CONV_CH, GDN_CONV_CH + vv, GDN_CONV_CH + vv + GDN_HEADS], axis=-1)
    qkv, conv_new = causal_conv(qkv, conv_state, conv_w)
    q, k, v = jnp.split(qkv, [qk, 2 * qk], axis=-1)
    q = l2_normalize(q.reshape(B, L, GDN_HEADS, GDN_DK))
    k = l2_normalize(k.reshape(B, L, GDN_HEADS, GDN_DK))
    v = v.reshape(B, L, GDN_HEADS, GDN_DV)
    beta = jax.nn.sigmoid(b_raw.astype(jnp.float32))
    g = -jnp.exp(a_log.astype(jnp.float32)) * jax.nn.softplus(a_raw.astype(jnp.float32) + dt_bias.astype(jnp.float32))
    o, s_fin = gated_delta_chunked(q, k, v, g, beta, s0)
    o = rms_norm(o, onorm).reshape(B, L, vv).astype(h.dtype) * jax.nn.silu(gate)
    return o @ w_out, s_fin, conv_new


def sb_project(h, w_in):
    B, L, _ = h.shape
    q, k, v = jnp.split(h @ w_in, 3, axis=-1)
    shp = (B, L, SB_HEADS, SB_DH)
    return q.reshape(shp), k.reshape(shp), v.reshape(shp)


def sb_attend(q, k, v, q_pos, k_pos):
    z = jnp.einsum('bqhd,bkhd->bhqk', q.astype(jnp.float32), k.astype(jnp.float32)) * SB_DH ** -0.5
    earlier = k_pos[None, :] < q_pos[:, None]
    log_1mb = jnp.where(earlier, jax.nn.log_sigmoid(-z), 0.0)
    surv = lax.cumsum(log_1mb, axis=3, reverse=True) - log_1mb
    a = jnp.where(earlier, jnp.exp(jax.nn.log_sigmoid(z) + surv), 0.0)
    return jnp.einsum('bhqk,bkhd->bqhd', a, v.astype(jnp.float32))


def sb_prompt(h, w_in, w_out):
    B, L, _ = h.shape
    q, k, v = sb_project(h, w_in)
    pos = jnp.arange(L)

    def block(b):
        start = b * SB_QBLOCK
        qb = lax.dynamic_slice_in_dim(q, start, SB_QBLOCK, axis=1)
        return sb_attend(qb, k, v, start + jnp.arange(SB_QBLOCK), pos)

    o = lax.map(block, jnp.arange(L // SB_QBLOCK))
    o = jnp.moveaxis(o, 0, 1).reshape(B, L, D_MODEL).astype(h.dtype)
    return o @ w_out, k, v


def sb_sample(h, cache_k, cache_v, w_in, w_out):
    B, L, _ = h.shape
    past = cache_k.shape[1]
    q, k, v = sb_project(h, w_in)
    kk = jnp.concatenate([cache_k.astype(k.dtype), k], axis=1)
    vv = jnp.concatenate([cache_v.astype(v.dtype), v], axis=1)
    o = sb_attend(q, kk, vv, past + jnp.arange(L), jnp.arange(past + L))
    o = o.reshape(B, L, D_MODEL).astype(h.dtype)
    return o @ w_out, k, v


def setup_inputs(seed: int = 0) -> dict:
    key = jax.random.key(seed)
    keys = iter(jax.random.split(key, 48))
    f32 = jnp.float32

    def nrm(shape, scale):
        return jax.random.normal(next(keys), shape, f32) * scale

    def gain(shape):
        return 1.0 + nrm(shape, 0.02)

    n_gla, n_band, n_gdn, n_sb = (_count(m) for m in range(N_MIXERS))
    band_rows = min(BAND_WINDOW, PAST_LEN)
    d = D_MODEL
    gla_cols = 2 * GLA_HEADS * GLA_DK + 2 * GLA_HEADS * GLA_DV + GLA_RANK
    gdn_cols = GDN_CONV_CH + GDN_HEADS * GDN_DV + 2 * GDN_HEADS
    dt = jnp.exp(jax.random.uniform(next(keys), (n_gdn, GDN_HEADS), f32, math.log(1e-3), math.log(1e-1)))
    a_log = jnp.log(jax.random.uniform(next(keys), (n_gdn, GDN_HEADS), f32, 1.0, 16.0))
    return {
        'x_prompt': nrm((BATCH, SEQ, d), 1.0),
        'x_sample': nrm((DEC_BATCH, DEC_SEQ, d), 1.0),
        'state_gla': nrm((n_gla, DEC_BATCH, GLA_HEADS, GLA_DK, GLA_DV), 0.1),
        'cache_band_k': nrm((n_band, DEC_BATCH, band_rows, BAND_HEADS, BAND_DH), 1.0),
        'cache_band_v': nrm((n_band, DEC_BATCH, band_rows, BAND_HEADS, BAND_DH), 1.0),
        'state_gdn': nrm((n_gdn, DEC_BATCH, GDN_HEADS, GDN_DK, GDN_DV), 0.1),
        'state_gdn_conv': nrm((n_gdn, DEC_BATCH, CONV_W - 1, GDN_CONV_CH), 1.0),
        'cache_sb_k': nrm((n_sb, DEC_BATCH, PAST_LEN, SB_HEADS, SB_DH), 1.0),
        'cache_sb_v': nrm((n_sb, DEC_BATCH, PAST_LEN, SB_HEADS, SB_DH), 1.0),
        'ffn1_norm': gain((DEPTH, d)),
        'ffn1_w_gu': nrm((DEPTH, d, 2 * D_FF), d ** -0.5),
        'ffn1_w_down': nrm((DEPTH, D_FF, d), D_FF ** -0.5),
        'mix_norm': gain((DEPTH, d)),
        'ffn2_norm': gain((DEPTH, d)),
        'ffn2_w_gu': nrm((DEPTH, d, 2 * D_FF), d ** -0.5),
        'ffn2_w_down': nrm((DEPTH, D_FF, d), D_FF ** -0.5),
        'gla_w_in': nrm((n_gla, d, gla_cols), d ** -0.5),
        'gla_w_gate2': nrm((n_gla, GLA_RANK, GLA_HEADS * GLA_DK), GLA_RANK ** -0.5),
        'gla_b_gate': nrm((n_gla, GLA_HEADS * GLA_DK), 0.1),
        'gla_onorm': gain((n_gla, GLA_DV)),
        'gla_w_out': nrm((n_gla, GLA_HEADS * GLA_DV, d), (GLA_HEADS * GLA_DV) ** -0.5),
        'band_w_in': nrm((n_band, d, 3 * d), d ** -0.5),
        'band_q_norm': gain((n_band, BAND_DH)),
        'band_k_norm': gain((n_band, BAND_DH)),
        'band_rel_bias': nrm((n_band, BAND_HEADS, 2 * REL_CLIP + 1), 0.1),
        'band_w_out': nrm((n_band, d, d), d ** -0.5),
        'gdn_w_in': nrm((n_gdn, d, gdn_cols), d ** -0.5),
        'gdn_conv_w': nrm((n_gdn, CONV_W, GDN_CONV_CH), CONV_W ** -0.5),
        'gdn_a_log': a_log,
        'gdn_dt_bias': dt + jnp.log(-jnp.expm1(-dt)),
        'gdn_onorm': gain((n_gdn, GDN_DV)),
        'gdn_w_out': nrm((n_gdn, GDN_HEADS * GDN_DV, d), (GDN_HEADS * GDN_DV) ** -0.5),
        'sb_w_in': nrm((n_sb, d, 3 * d), d ** -0.5),
        'sb_w_out': nrm((n_sb, d, d), d ** -0.5),
    }


def reference(x_prompt, x_sample, state_gla, cache_band_k, cache_band_v, state_gdn, state_gdn_conv,
              cache_sb_k, cache_sb_v, ffn1_norm, ffn1_w_gu, ffn1_w_down, mix_norm, ffn2_norm,
              ffn2_w_gu, ffn2_w_down, gla_w_in, gla_w_gate2, gla_b_gate, gla_onorm, gla_w_out,
              band_w_in, band_q_norm, band_k_norm, band_rel_bias, band_w_out, gdn_w_in, gdn_conv_w,
              gdn_a_log, gdn_dt_bias, gdn_onorm, gdn_w_out, sb_w_in, sb_w_out):
    past = cache_sb_k.shape[2]
    xp, xs = x_prompt, x_sample
    bp = xp.shape[0]
    gla_p, gla_s = [], []
    band_kp, band_vp, band_ks, band_vs = [], [], [], []
    gdn_p, gdn_cp, gdn_s, gdn_cs = [], [], [], []
    sb_kp, sb_vp, sb_ks, sb_vs = [], [], [], []
    for i in range(DEPTH):
        m, j = i % N_MIXERS, i // N_MIXERS
        xp = xp + 0.5 * swiglu_ffn(rms_norm(xp, ffn1_norm[i]), ffn1_w_gu[i], ffn1_w_down[i])
        xs = xs + 0.5 * swiglu_ffn(rms_norm(xs, ffn1_norm[i]), ffn1_w_gu[i], ffn1_w_down[i])
        hp, hs = rms_norm(xp, mix_norm[i]), rms_norm(xs, mix_norm[i])
        if m == 0:
            w = (gla_w_in[j], gla_w_gate2[j], gla_b_gate[j], gla_onorm[j], gla_w_out[j])
            zero = jnp.zeros((bp, GLA_HEADS, GLA_DK, GLA_DV), jnp.float32)
            yp, sp = gla_mixer(hp, zero, *w)
            ys, ss = gla_mixer(hs, state_gla[j], *w)
            gla_p.append(sp)
            gla_s.append(ss)
        elif m == 1:
            w = (band_w_in[j], band_q_norm[j], band_k_norm[j], band_rel_bias[j], band_w_out[j])
            yp, kp, vp = band_prompt(hp, *w)
            ys, ks, vs = band_sample(hs, cache_band_k[j], cache_band_v[j], past, *w)
            band_kp.append(kp)
            band_vp.append(vp)
            band_ks.append(ks)
            band_vs.append(vs)
        elif m == 2:
            w = (gdn_w_in[j], gdn_conv_w[j], gdn_a_log[j], gdn_dt_bias[j], gdn_onorm[j], gdn_w_out[j])
            zs = jnp.zeros((bp, GDN_HEADS, GDN_DK, GDN_DV), jnp.float32)
            zc = jnp.zeros((bp, CONV_W - 1, GDN_CONV_CH), hp.dtype)
            yp, sp, cp = gdn_mixer(hp, zc, zs, *w)
            ys, ss, cs = gdn_mixer(hs, state_gdn_conv[j], state_gdn[j], *w)
            gdn_p.append(sp)
            gdn_cp.append(cp)
            gdn_s.append(ss)
            gdn_cs.append(cs)
        else:
            yp, kp, vp = sb_prompt(hp, sb_w_in[j], sb_w_out[j])
            ys, ks, vs = sb_sample(hs, cache_sb_k[j], cache_sb_v[j], sb_w_in[j], sb_w_out[j])
            sb_kp.append(kp)
            sb_vp.append(vp)
            sb_ks.append(ks)
            sb_vs.append(vs)
        xp = xp + yp
        xs = xs + ys
        xp = xp + 0.5 * swiglu_ffn(rms_norm(xp, ffn2_norm[i]), ffn2_w_gu[i], ffn2_w_down[i])
        xs = xs + 0.5 * swiglu_ffn(rms_norm(xs, ffn2_norm[i]), ffn2_w_gu[i], ffn2_w_down[i])
    return (xp, xs,
            jnp.stack(gla_p), jnp.stack(gla_s),
            jnp.stack(band_kp), jnp.stack(band_vp), jnp.stack(band_ks), jnp.stack(band_vs),
            jnp.stack(gdn_p), jnp.stack(gdn_cp), jnp.stack(gdn_s), jnp.stack(gdn_cs),
            jnp.stack(sb_kp), jnp.stack(sb_vp), jnp.stack(sb_ks), jnp.stack(sb_vs))
```

```cpp
#include <hip/hip_runtime.h>
#include <cstdio>
#include <cstdint>


namespace pg8 {
#define PG8_LAS __attribute__((address_space(3)))
typedef unsigned short bf16_t;
typedef short bf16x8 __attribute__((ext_vector_type(8)));
typedef float f32x4 __attribute__((ext_vector_type(4)));
typedef unsigned u32x4 __attribute__((ext_vector_type(4)));
constexpr int BM = 256, BK = 64, HALF = 128, HTB = HALF * BK * 2  , STAGE_BYTES = 8 * HTB, NXCD = 8, WGM = 8;

__host__ __device__ __forceinline__ int lds_byte(int r, int c) { const int st = (r >> 4) * 2 + (c >> 5), rr = r & 15, cc = c & 31, ob = rr * 64 + cc * 2; return st * 1024 + (ob ^ (((ob >> 9) & 1) << 5)); }
__host__ __device__ __forceinline__ void stage_rc(int b, int& R, int& C) { const int st = b / 1024, sb = b % 1024, swz = sb ^ (((sb >> 9) & 1) << 5); R = (st >> 1) * 16 + swz / 64; C = (st & 1) * 32 + (swz % 64) / 2; }
__host__ __device__ __forceinline__ int perm32(int rho) { const int n = rho >> 4, i = rho & 15; return 8 * (i >> 2) + 4 * n + (i & 3); }

struct Unit { int pm, pn; };
struct Gemm { const bf16_t* A; const bf16_t* Bt; int M, N, K; };

struct StaticOrder {
    int nM, nN, nwg, G, c;
    __host__ __device__ void init(int M, int N, int G_, int c_) { nM = M / BM; nN = N / BM; nwg = nM * nN; G = G_; c = c_; }
    __host__ __device__ bool next(int i, Unit& u) const {
        const long L = (long)i * G + c; if (L >= nwg) return false;
        int wgid = (int)L; { const int q = nwg / NXCD, r = nwg % NXCD, xcd = wgid % NXCD, off = wgid / NXCD; wgid = (xcd < r ? xcd * (q + 1) : r * (q + 1) + (xcd - r) * q) + off; }
        const int nig = WGM * nN, gid = wgid / nig, fm = gid * WGM, gsz = (nM - fm) < WGM ? (nM - fm) : WGM;
        u.pm = fm + ((wgid % nig) % gsz); u.pn = (wgid % nig) / gsz; return true;
    }
    __device__ __forceinline__ void a_ready(const Unit&) const {}
    __device__ __forceinline__ void done(const Unit&) const {}
};
__device__ __forceinline__ unsigned cvt_pk_bf16(float lo, float hi) { unsigned r; asm volatile("v_cvt_pk_bf16_f32 %0, %1, %2" : "=v"(r) : "v"(lo), "v"(hi)); return r; }

template <class Epi, class Sched, bool ALIGN_EPI = false, bool SP2 = false>
__device__ __forceinline__ void gemm_phase(PG8_LAS unsigned char* lds, const Gemm g, const Sched& S, const Epi& E) {
    int tid = threadIdx.x; asm volatile("" : "+v"(tid)); const int wid = __builtin_amdgcn_readfirstlane(tid >> 6), lane = tid & 63, wr = wid >> 2, wc = wid & 3, fr = lane & 15, fq = lane >> 4;
    const int K = g.K, nt = K / BK;
    unsigned voffA[2], voffB[2];
#pragma unroll
    for (int i = 0; i < 2; ++i) { int R, C; stage_rc(tid * 16 + i * 8192, R, C); const int Rb = Epi::PERM ? ((R & ~31) + perm32(R & 31)) : R;
        voffA[i] = (unsigned)(R * K + C) * 2u; voffB[i] = (unsigned)(Rb * K + C) * 2u; }
    const size_t kstep = (size_t)(BK * 2);
    const size_t hstep = (size_t)HALF * K * 2;
    const size_t tstep = 2 * hstep;
    const unsigned ldsw = (unsigned)wid * 1024u;
    const int aoff = lds_byte(wr * 64 + fr, fq * 8), boff = lds_byte(wc * 32 + fr, fq * 8);
#define PG8_SA(b, h) (((b) * 2 + (h)) * HTB)
#define PG8_SB(b, h) ((4 + (b) * 2 + (h)) * HTB)
#define PG8_STAGE(bufoff, gbase, voff) do { _Pragma("unroll") for (int _i = 0; _i < 2; ++_i) \
        __builtin_amdgcn_global_load_lds((const unsigned*)((const char*)(gbase) + (voff)[_i]), (PG8_LAS unsigned*)(lds + (bufoff) + ldsw + _i * 8192), 16, 0, 0); } while (0)
#define PG8_LDA(dst, b, h) do { _Pragma("unroll") for (int m = 0; m < 4; ++m) _Pragma("unroll") for (int k = 0; k < 2; ++k) dst[m][k] = *(const PG8_LAS bf16x8*)(lds + PG8_SA(b, h) + aoff + m * 2048 + k * 1024); } while (0)
#define PG8_LDB(dst, b, h) do { _Pragma("unroll") for (int n = 0; n < 2; ++n) _Pragma("unroll") for (int k = 0; k < 2; ++k) dst[n][k] = *(const PG8_LAS bf16x8*)(lds + PG8_SB(b, h) + boff + n * 2048 + k * 1024); } while (0)
#define PG8_MMA(ai, bj, At, Bt) do { __builtin_amdgcn_s_setprio(1); _Pragma("unroll") for (int m = 0; m < 4; ++m) _Pragma("unroll") for (int n = 0; n < 2; ++n) _Pragma("unroll") for (int k = 0; k < 2; ++k) \
        acc[ai][bj][m][n] = __builtin_amdgcn_mfma_f32_16x16x32_bf16(Bt[n][k], At[m][k], acc[ai][bj][m][n], 0, 0, 0); __builtin_amdgcn_s_setprio(0); } while (0)
#define PG8_WAIT_V(n) asm volatile("s_waitcnt vmcnt(" #n ")" ::: "memory")
#define PG8_WAIT_L(n) asm volatile("s_waitcnt lgkmcnt(" #n ")" ::: "memory")
#define PG8_BAR __builtin_amdgcn_s_barrier()
#define PG8_SCHED __builtin_amdgcn_sched_barrier(0)
    Unit cur, nxt; int ui = 0;
    if (!S.next(0, cur)) return;
    f32x4 acc[2][2][4][2];
#pragma unroll
    for (int a = 0; a < 2; ++a)
#pragma unroll
        for (int b = 0; b < 2; ++b)
#pragma unroll
            for (int m = 0; m < 4; ++m)
#pragma unroll
                for (int n = 0; n < 2; ++n) acc[a][b][m][n] = (f32x4){0.f, 0.f, 0.f, 0.f};
    bf16x8 At[4][2], B0[2][2], B1[2][2];
    const char* cA = (const char*)g.A + (size_t)cur.pm * tstep; const char* cB = (const char*)g.Bt + (size_t)cur.pn * tstep;
    S.a_ready(cur);
    if constexpr (SP2) {
        PG8_STAGE(PG8_SB(0, 0), cB, voffB); PG8_STAGE(PG8_SB(0, 1), cB + hstep, voffB); PG8_STAGE(PG8_SA(0, 0), cA, voffA); PG8_STAGE(PG8_SA(0, 1), cA + hstep, voffA);
        if (wr == 1) PG8_BAR;
        PG8_WAIT_V(2); PG8_BAR;
        PG8_STAGE(PG8_SB(1, 0), cB + kstep, voffB); PG8_STAGE(PG8_SA(1, 0), cA + kstep, voffA); PG8_STAGE(PG8_SB(1, 1), cB + hstep + kstep, voffB);
        PG8_WAIT_V(6); PG8_BAR;
    } else {
        PG8_STAGE(PG8_SB(0, 0), cB, voffB); PG8_STAGE(PG8_SA(0, 0), cA, voffA); PG8_STAGE(PG8_SB(0, 1), cB + hstep, voffB); PG8_STAGE(PG8_SA(0, 1), cA + hstep, voffA);
        if (wr == 1) PG8_BAR;
        PG8_WAIT_V(4); PG8_BAR;
        PG8_STAGE(PG8_SB(1, 0), cB + kstep, voffB); PG8_STAGE(PG8_SA(1, 0), cA + kstep, voffA); PG8_STAGE(PG8_SB(1, 1), cB + hstep + kstep, voffB);
        PG8_WAIT_V(6); PG8_BAR;
    }
    for (;;) {
        const bool has_next = S.next(ui + 1, nxt);
        const char* nA = has_next ? (const char*)g.A + (size_t)nxt.pm * tstep : cA; const char* nB = has_next ? (const char*)g.Bt + (size_t)nxt.pn * tstep : cB;
        for (int t = 0; t < nt; t += 2) {
            const bool last = (t == nt - 2);
            const char* a1 = cA + (size_t)(t + 1) * kstep;
            const char* a2 = last ? nA : cA + (size_t)(t + 2) * kstep; const char* b2 = last ? nB : cB + (size_t)(t + 2) * kstep;
            const char* a3 = a2 + kstep; const char* b3 = b2 + kstep;
            if (last && has_next) S.a_ready(nxt);
            if constexpr (SP2) {
            PG8_LDB(B0, 0, 0); PG8_LDB(B1, 0, 1); PG8_SCHED; PG8_LDA(At, 0, 0); PG8_STAGE(PG8_SA(1, 1), a1 + hstep, voffA);
            PG8_WAIT_V(8); PG8_WAIT_L(0); PG8_BAR; PG8_MMA(0, 0, At, B0); PG8_MMA(0, 1, At, B1); PG8_BAR; PG8_SCHED;
            PG8_LDA(At, 0, 1); PG8_STAGE(PG8_SB(0, 0), b2, voffB); PG8_STAGE(PG8_SB(0, 1), b2 + hstep, voffB); PG8_STAGE(PG8_SA(0, 0), a2, voffA);
            PG8_WAIT_V(8); PG8_WAIT_L(0); PG8_BAR; PG8_MMA(1, 0, At, B0); PG8_MMA(1, 1, At, B1); PG8_BAR; PG8_SCHED;
            PG8_LDB(B0, 1, 0); PG8_LDB(B1, 1, 1); PG8_SCHED; PG8_LDA(At, 1, 0); PG8_STAGE(PG8_SA(0, 1), a2 + hstep, voffA);
            PG8_WAIT_V(8); PG8_WAIT_L(0); PG8_BAR; PG8_MMA(0, 0, At, B0); PG8_MMA(0, 1, At, B1); PG8_BAR; PG8_SCHED;
            PG8_LDA(At, 1, 1); PG8_STAGE(PG8_SB(1, 0), b3, voffB); PG8_STAGE(PG8_SB(1, 1), b3 + hstep, voffB); PG8_STAGE(PG8_SA(1, 0), a3, voffA);
            PG8_WAIT_V(8); PG8_WAIT_L(0); PG8_BAR; PG8_MMA(1, 0, At, B0); PG8_MMA(1, 1, At, B1); PG8_BAR; PG8_SCHED;
            } else {
            PG8_LDB(B0, 0, 0); PG8_SCHED; PG8_LDA(At, 0, 0); PG8_STAGE(PG8_SA(1, 1), a1 + hstep, voffA);
            PG8_WAIT_L(8); PG8_BAR; PG8_WAIT_L(0); PG8_MMA(0, 0, At, B0); PG8_BAR; PG8_SCHED;
            PG8_LDB(B1, 0, 1); PG8_STAGE(PG8_SB(0, 0), b2, voffB);
            PG8_BAR; PG8_WAIT_L(0); PG8_MMA(0, 1, At, B1); PG8_BAR;
            PG8_LDA(At, 0, 1); PG8_STAGE(PG8_SA(0, 0), a2, voffA);
            PG8_BAR; PG8_WAIT_L(0); PG8_MMA(1, 0, At, B0); PG8_BAR; PG8_SCHED;
            PG8_STAGE(PG8_SB(0, 1), b2 + hstep, voffB);
            PG8_WAIT_V(6); PG8_BAR; PG8_MMA(1, 1, At, B1); PG8_BAR;
            PG8_LDB(B0, 1, 0); PG8_SCHED; PG8_LDA(At, 1, 0); PG8_STAGE(PG8_SA(0, 1), a2 + hstep, voffA);
            PG8_WAIT_L(8); PG8_BAR; PG8_WAIT_L(0); PG8_MMA(0, 0, At, B0); PG8_BAR; PG8_SCHED;
            PG8_LDB(B1, 1, 1); PG8_STAGE(PG8_SB(1, 0), b3, voffB);
            PG8_BAR; PG8_WAIT_L(0); PG8_MMA(0, 1, At, B1); PG8_BAR;
            PG8_LDA(At, 1, 1); PG8_STAGE(PG8_SA(1, 0), a3, voffA);
            PG8_BAR; PG8_WAIT_L(0); PG8_MMA(1, 0, At, B0); PG8_BAR; PG8_SCHED;
            PG8_STAGE(PG8_SB(1, 1), b3 + hstep, voffB);
            PG8_WAIT_V(6); PG8_BAR; PG8_MMA(1, 1, At, B1); PG8_BAR;
            }
        }
        if constexpr (ALIGN_EPI) { if (wr == 0) PG8_BAR; }
        if constexpr (!Epi::AFTER_DRAIN) { E(acc, cur, wr, wc, fr, fq); S.done(cur); }
        if (!has_next) break;
#pragma unroll
        for (int a = 0; a < 2; ++a)
#pragma unroll
            for (int b = 0; b < 2; ++b)
#pragma unroll
                for (int m = 0; m < 4; ++m)
#pragma unroll
                    for (int n = 0; n < 2; ++n) acc[a][b][m][n] = (f32x4){0.f, 0.f, 0.f, 0.f};
        cur = nxt; cA = nA; cB = nB; ++ui;
        if constexpr (ALIGN_EPI) { if (wr == 1) PG8_BAR; }
    }
    PG8_WAIT_V(0);
    if constexpr (!ALIGN_EPI) { if (wr == 0) PG8_BAR; }
    PG8_BAR;
    if constexpr (Epi::AFTER_DRAIN) { E.fused(acc, cur, wr, wc, fr, fq, lds, wid, lane); S.done(cur); }
#undef PG8_SA
#undef PG8_SB
#undef PG8_STAGE
#undef PG8_LDA
#undef PG8_LDB
#undef PG8_MMA
#undef PG8_WAIT_V
#undef PG8_WAIT_L
#undef PG8_BAR
#undef PG8_SCHED
}
}

#define LAS __attribute__((address_space(3)))
typedef unsigned short bf16_t;
typedef short bf16x8 __attribute__((ext_vector_type(8)));
typedef short s16x4 __attribute__((ext_vector_type(4)));
typedef float f32x4 __attribute__((ext_vector_type(4)));
typedef float f32x2 __attribute__((ext_vector_type(2)));
typedef unsigned u32x4 __attribute__((ext_vector_type(4)));
typedef unsigned u32x2 __attribute__((ext_vector_type(2)));
#define DI __device__ __forceinline__
#define MFMA16(a, b, c) __builtin_amdgcn_mfma_f32_16x16x32_bf16((a), (b), (c), 0, 0, 0)

constexpr int D = 1024, FF = 2816, MP = 16384, MS = 2048, M = MP + MS, SEQ = 8192;
constexpr float EPS = 1e-6f;
constexpr int NT = 512;
constexpr int NSSQ = 13;

constexpr size_t O_Y = 0;
constexpr size_t O_GLA_P = (size_t)M * D;
constexpr size_t O_GLA_S = O_GLA_P + 2 * 4 * 128 * 256;
constexpr size_t O_BK_P = O_GLA_S + 32 * 4 * 128 * 256;
constexpr size_t O_BV_P = O_BK_P + 2 * 512 * 1024;
constexpr size_t O_BK_S = O_BV_P + 2 * 512 * 1024;
constexpr size_t O_BV_S = O_BK_S + 32 * 64 * 1024;
constexpr size_t O_GDN_P = O_BV_S + 32 * 64 * 1024;
constexpr size_t O_GDNC_P = O_GDN_P + 2 * 8 * 128 * 128;
constexpr size_t O_GDN_S = O_GDNC_P + 2 * 3 * 3072;
constexpr size_t O_GDNC_S = O_GDN_S + 32 * 8 * 128 * 128;
constexpr size_t O_SBK_P = O_GDNC_S + 32 * 3 * 3072;
constexpr size_t O_SBV_P = O_SBK_P + (size_t)MP * 1024;
constexpr size_t O_SBK_S = O_SBV_P + (size_t)MP * 1024;
constexpr size_t O_SBV_S = O_SBK_S + (size_t)MS * 1024;
constexpr size_t O_END = O_SBV_S + (size_t)MS * 1024;

constexpr size_t MiB = 1u << 20;
constexpr size_t WS_CTL = 0, CTL_ZERO_BYTES = 128 * 1024;
constexpr int CW_BAR = 4096;
constexpr size_t WS_GNB = 128 * 1024;
constexpr size_t SZ_WUP = (size_t)2 * FF * D * 2, SZ_WDN = (size_t)D * FF * 2;
constexpr size_t WS_SSQ = 2 * MiB;
constexpr size_t WS_WFFN = 18 * MiB;
constexpr size_t SZ_WFFN_L = 2 * (SZ_WUP + SZ_WDN);
constexpr size_t WS_WGLA_IN = WS_WFFN + 4 * SZ_WFFN_L;
constexpr size_t WS_WGLA_OUT = WS_WGLA_IN + (size_t)3584 * D * 2;
constexpr size_t WS_WBAND_IN = WS_WGLA_OUT + (size_t)D * D * 2;
constexpr size_t WS_WBAND_OUT = WS_WBAND_IN + (size_t)3072 * D * 2;
constexpr size_t WS_WGDN_IN = WS_WBAND_OUT + (size_t)D * D * 2;
constexpr size_t WS_WGDN_OUT = WS_WGDN_IN + (size_t)4352 * D * 2;
constexpr size_t WS_WSB_IN = WS_WGDN_OUT + (size_t)D * D * 2;
constexpr size_t WS_WSB_OUT = WS_WSB_IN + (size_t)3072 * D * 2;
constexpr size_t WS_XB = (WS_WSB_OUT + (size_t)D * D * 2 + 4095) & ~(size_t)4095;
constexpr size_t WS_ACT = WS_XB + (size_t)M * D * 2;
constexpr size_t WS_OB = WS_ACT + (size_t)M * FF * 2;
constexpr size_t WS_MIX = WS_OB + (size_t)M * D * 2;
constexpr size_t GLA_Q = WS_MIX;
constexpr size_t GLA_K = GLA_Q + (size_t)M * 512 * 2;
constexpr size_t GLA_V = GLA_K + (size_t)M * 512 * 2;
constexpr size_t GLA_R = GLA_V + (size_t)M * 1024 * 2;
constexpr size_t GLA_LA = GLA_R + (size_t)M * 1024 * 2;
constexpr size_t GLA_UT = GLA_LA + (size_t)M * 512 * 4;
constexpr size_t GLA_DL = GLA_UT + (size_t)1152 * 32768 * 4;
constexpr size_t GLA_ST = GLA_DL + (size_t)1152 * 128 * 4;
constexpr size_t GLA_END = GLA_ST + (size_t)1152 * 32768 * 2;
constexpr size_t AT_Q = WS_MIX, AT_K = AT_Q + (size_t)M * 1024 * 2, AT_V = AT_K + (size_t)M * 1024 * 2, AT_END = AT_V + (size_t)M * 1024 * 2;
constexpr size_t GDN_QKV = WS_MIX;
constexpr size_t GDN_GG = GDN_QKV + (size_t)M * 3072 * 2;
constexpr size_t GDN_BG = GDN_GG + (size_t)M * 1024 * 2;
constexpr size_t GDN_QE = GDN_BG + (size_t)M * 16 * 4;
constexpr size_t GDN_WN = GDN_QE + (size_t)2304 * 8192 * 2;
constexpr size_t GDN_KLT = GDN_WN + (size_t)2304 * 8192 * 2;
constexpr size_t GDN_ATT = GDN_KLT + (size_t)2304 * 8192 * 2;
constexpr size_t GDN_UT = GDN_ATT + (size_t)2304 * 4096 * 2;
constexpr size_t GDN_STB = GDN_UT + (size_t)2304 * 8192 * 4;
constexpr size_t GDN_VNT = GDN_STB + (size_t)2304 * 16384 * 2;
constexpr size_t GDN_DLAST = GDN_VNT + (size_t)2304 * 8192 * 2;
constexpr size_t GDN_END = GDN_DLAST + (size_t)2304 * 4;
constexpr size_t WS_END = (GDN_END > GLA_END ? GDN_END : GLA_END);
static_assert(AT_END <= WS_END, "ws map");

constexpr int LDS_BYTES = 147456;
constexpr int RING_BYTES = 131072;
constexpr int MISC_OFF = RING_BYTES + 320;

DI int otid() { int t = threadIdx.x; asm volatile("" : "+v"(t)); return t; }
DI unsigned pk_bf16(float lo, float hi) { typedef __bf16 bf2 __attribute__((ext_vector_type(2))); f32x2 v = {lo, hi}; bf2 b = __builtin_convertvector(v, bf2); return __builtin_bit_cast(unsigned, b); }
DI float bf_lo(unsigned u) { return __uint_as_float(u << 16); }
DI float bf_hi(unsigned u) { return __uint_as_float(u & 0xffff0000u); }
DI float bf2f(bf16_t b) { return __uint_as_float(((unsigned)b) << 16); }
DI float fast_exp(float x) { return __builtin_amdgcn_exp2f(x * 1.4426950408889634f); }
DI float fast_log(float x) { return __builtin_amdgcn_logf(x) * 0.6931471805599453f; }
DI float fast_rcp(float x) { return __builtin_amdgcn_rcpf(x); }
DI float sigmoidf_(float x) { return fast_rcp(1.0f + fast_exp(-x)); }
DI float siluf_(float x) { return x * sigmoidf_(x); }
DI float softplusf_(float x) { return fmaxf(x, 0.f) + fast_log(1.0f + fast_exp(-fabsf(x))); }
DI float rsq(float x) { return __builtin_amdgcn_rsqf(x); }
DI float row_rs(const float* ssq, int row) { const f32x4* p = (const f32x4*)(ssq + (size_t)row * 16); const f32x4 a = p[0], b = p[1], c = p[2], d = p[3];
    const f32x4 s = (a + b) + (c + d); return rsq(((s[0] + s[1]) + (s[2] + s[3])) * (1.0f / 1024.0f) + EPS); }
DI float wave_sum(float v) {
#pragma unroll
    for (int o = 1; o < 64; o <<= 1) v += __shfl_xor(v, o);
    return v;
}
DI bf16x8 ldfrag_l(const LAS unsigned char* p) { return *(const LAS bf16x8*)p; }
DI bf16x8 ldfrag_g(const bf16_t* p) { return *(const bf16x8*)p; }
DI bf16x8 ldfrag2_g(const bf16_t* p0, const bf16_t* p1) { const s16x4 a = *(const s16x4*)p0, b = *(const s16x4*)p1; return __builtin_shufflevector(a, b, 0, 1, 2, 3, 4, 5, 6, 7); }
DI s16x4 tr4(const LAS unsigned char* p) { typedef short v4i16 __attribute__((ext_vector_type(4))); return __builtin_bit_cast(s16x4, __builtin_amdgcn_ds_read_tr16_b64_v4i16((LAS v4i16*)p)); }
DI bf16x8 trfrag(const LAS unsigned char* p0, const LAS unsigned char* p1) { const s16x4 a = tr4(p0), b = tr4(p1); return __builtin_shufflevector(a, b, 0, 1, 2, 3, 4, 5, 6, 7); }
DI bf16x8 packfrag(const f32x4& a, const f32x4& b) { u32x4 w; w.x = pk_bf16(a[0], a[1]); w.y = pk_bf16(a[2], a[3]); w.z = pk_bf16(b[0], b[1]); w.w = pk_bf16(b[2], b[3]); return __builtin_bit_cast(bf16x8, w); }
DI void unpack8(const u32x4 w, float (&f)[8]) { f[0] = bf_lo(w.x); f[1] = bf_hi(w.x); f[2] = bf_lo(w.y); f[3] = bf_hi(w.y); f[4] = bf_lo(w.z); f[5] = bf_hi(w.z); f[6] = bf_lo(w.w); f[7] = bf_hi(w.w); }
DI u32x4 pack8(const float (&f)[8]) { u32x4 w; w.x = pk_bf16(f[0], f[1]); w.y = pk_bf16(f[2], f[3]); w.z = pk_bf16(f[4], f[5]); w.w = pk_bf16(f[6], f[7]); return w; }

struct KArgs { const float* in[34]; float* out; unsigned char* ws; };
constexpr int ARGS_OFF = RING_BYTES + 1024;
struct InTab { const LAS unsigned* t;
    DI const void* ptr(int i) const { const unsigned lo = __builtin_amdgcn_readfirstlane(t[2 * i]), hi = __builtin_amdgcn_readfirstlane(t[2 * i + 1]); return (const void*)(((unsigned long long)hi << 32) | lo); }
    DI const float* operator[](int i) const { return (const float*)ptr(i); } };
struct Args { InTab in; float* out; unsigned char* ws; };
DI void store_args(const KArgs& k, LAS unsigned char* lds) {
    if (threadIdx.x < 36) { const unsigned long long v = threadIdx.x < 34 ? (unsigned long long)k.in[threadIdx.x] : (threadIdx.x == 34 ? (unsigned long long)k.out : (unsigned long long)k.ws);
        *(LAS unsigned long long*)(lds + ARGS_OFF + 8 * threadIdx.x) = v; }
}
DI Args load_args(LAS unsigned char* lds) { Args a; a.in.t = (const LAS unsigned*)(lds + ARGS_OFF); a.out = (float*)a.in.ptr(34); a.ws = (unsigned char*)a.in.ptr(35); return a; }


#define XB_TMO      128
#define XB_XCNT(j)  (256  + 64 * (j))
#define XB_XSUB(j)  (1280 + 64 * (j))
#define XB_XGEN(j)  (2304 + 64 * (j))
#define XB_TOP      3328
#define XB_TOPGEN   3392
#define XCD_BAR_WORDS 3456
#define XB_SPIN_CAP (1u << 18)

__device__ __forceinline__ unsigned xb_ld(unsigned* p)              { return __hip_atomic_load(p, __ATOMIC_RELAXED, __HIP_MEMORY_SCOPE_AGENT); }
__device__ __forceinline__ unsigned xb_add(unsigned* p, unsigned v) { return __hip_atomic_fetch_add(p, v, __ATOMIC_RELAXED, __HIP_MEMORY_SCOPE_AGENT); }
__device__ __forceinline__ unsigned xb_xcc_id() { return (unsigned)__builtin_amdgcn_s_getreg((3 << 11) | 20) & 0xFu; }
#define XB_SPIN(cond, bar) do { unsigned _sp = 0; while (cond) { __builtin_amdgcn_s_sleep(1); \
    if ((++_sp & 255u) == 0u) { if (xb_ld(&(bar)[XB_TMO])) break; if (_sp > XB_SPIN_CAP) { atomicAdd(&(bar)[XB_TMO], 1u); break; } } } } while (0)

struct XcdBarrier {
    unsigned* bar; unsigned x;
    volatile LAS unsigned* st;
};

__device__ __forceinline__ XcdBarrier xcd_barrier_post(unsigned* bar, volatile LAS unsigned* st) {
    XcdBarrier b; b.bar = bar; b.x = xb_xcc_id(); b.st = st;
    if (threadIdx.x == 0) (void)xb_add(&bar[XB_XCNT(b.x)], 1u);
    return b;
}
__device__ __forceinline__ void xcd_barrier_complete(unsigned* bar, unsigned x, unsigned& nloc, unsigned& nx) {
    const unsigned G = gridDim.x * gridDim.y * gridDim.z;
    unsigned sum, cnt, mine, sp = 0u;
    for (;;) {
        sum = 0u; cnt = 0u; mine = 0u;
#pragma unroll
        for (unsigned j = 0; j < 16; ++j) { const unsigned c = xb_ld(&bar[XB_XCNT(j)]); sum += c; cnt += (c > 0u) ? 1u : 0u; mine = (j == x) ? c : mine; }
        if (sum == G) break;
        __builtin_amdgcn_s_sleep(1);
        if ((++sp & 255u) == 0u) { if (xb_ld(&bar[XB_TMO])) break; if (sp > XB_SPIN_CAP) { atomicAdd(&bar[XB_TMO], 1u); break; } }
    }
    nloc = mine > 0u ? mine : 1u; nx = cnt > 0u ? cnt : 1u;
}

__device__ __forceinline__ void xcd_barrier(const XcdBarrier& b) {
    asm volatile("s_waitcnt vmcnt(0)" ::: "memory");
    __syncthreads();
    if (threadIdx.x == 0) {
        unsigned* bar = b.bar;
        __builtin_amdgcn_s_waitcnt(0);
        unsigned nloc = b.st[0], nx = b.st[1];
        if (nloc == 0u) { xcd_barrier_complete(bar, b.x, nloc, nx); b.st[0] = nloc; b.st[1] = nx; }
        const unsigned old = xb_add(&bar[XB_XSUB(b.x)], 1u);
        const unsigned gen = old / nloc;
        if (old + 1u == (gen + 1u) * nloc) {
            __builtin_amdgcn_fence(__ATOMIC_RELEASE, "agent");
            asm volatile("s_waitcnt vmcnt(0)" ::: "memory");
            const unsigned og = xb_add(&bar[XB_TOP], 1u);
            const unsigned tg = og / nx;
            if (og + 1u == (tg + 1u) * nx) xb_add(&bar[XB_TOPGEN], 1u);
            else XB_SPIN(xb_ld(&bar[XB_TOPGEN]) == tg, bar);
            __builtin_amdgcn_fence(__ATOMIC_ACQUIRE, "agent");
            xb_add(&bar[XB_XGEN(b.x)], 1u);
            asm volatile("s_waitcnt vmcnt(0)" ::: "memory");
        } else {
            XB_SPIN(xb_ld(&bar[XB_XGEN(b.x)]) == gen, bar);
            __builtin_amdgcn_fence(__ATOMIC_ACQUIRE, "agent");
            asm volatile("s_waitcnt vmcnt(0)" ::: "memory");
        }
    }
    __syncthreads();
}

typedef f32x4 acc_t[2][2][4][2];

struct EpiSwiglu {
    static constexpr bool PERM = true, AFTER_DRAIN = false;
    bf16_t* ACT; const float* ssq;
    DI void operator()(const acc_t& acc, const pg8::Unit& u, int wr, int wc, int fr, int fq) const {
        const int row0 = u.pm * 256 + wr * 64 + fr, col0 = u.pn * 128 + wc * 32 + 8 * fq;
#pragma unroll
        for (int ai = 0; ai < 2; ++ai)
#pragma unroll
            for (int m = 0; m < 4; ++m) {
                const int row = row0 + ai * 128 + m * 16;
                const float rs = row_rs(ssq, row);
                float o[8];
#pragma unroll
                for (int n = 0; n < 2; ++n)
#pragma unroll
                    for (int i = 0; i < 4; ++i) { const float g = acc[ai][0][m][n][i] * rs, uu = acc[ai][1][m][n][i] * rs; o[n * 4 + i] = g * uu * fast_rcp(1.0f + fast_exp(-g)); }
                *(u32x4*)(ACT + (size_t)row * FF + col0) = pack8(o);
            }
    }
};
struct EpiResid {
    static constexpr bool PERM = false, AFTER_DRAIN = false;
    float* X; bf16_t* XB; float* ssq_next; float scale;
    DI void operator()(const acc_t& acc, const pg8::Unit& u, int wr, int wc, int fr, int fq) const {
        const int row0 = u.pm * 256 + wr * 64 + fr, col0 = u.pn * 256 + wc * 32 + 4 * fq;
#pragma unroll
        for (int ai = 0; ai < 2; ++ai)
#pragma unroll
            for (int m = 0; m < 4; ++m) {
                const int row = row0 + ai * 128 + m * 16; float ss = 0.f;
#pragma unroll
                for (int bj = 0; bj < 2; ++bj)
#pragma unroll
                    for (int n = 0; n < 2; ++n) {
                        const size_t off = (size_t)row * D + col0 + bj * 128 + n * 16;
                        const f32x4 xo = *(const f32x4*)(X + off); const f32x4 xn = xo + acc[ai][bj][m][n] * scale;
                        *(f32x4*)(X + off) = xn;
                        u32x2 w; w.x = pk_bf16(xn[0], xn[1]); w.y = pk_bf16(xn[2], xn[3]); *(u32x2*)(XB + off) = w;
                        ss += (xn[0] * xn[0] + xn[1] * xn[1]) + (xn[2] * xn[2] + xn[3] * xn[3]);
                    }
                ss += __shfl_xor(ss, 16); ss += __shfl_xor(ss, 32);
                if (fq == 0) ssq_next[(size_t)row * 16 + u.pn * 4 + wc] = ss;
            }
    }
};
struct EpiGlaIn {
    static constexpr bool PERM = true, AFTER_DRAIN = false;
    const float* ssq; bf16_t *Q, *K, *V, *R; float* LA; const float* b_gate;
    DI void operator()(const acc_t& acc, const pg8::Unit& u, int wr, int wc, int fr, int fq) const {
        const int row0 = u.pm * 256 + wr * 64 + fr, pn = u.pn, cw = wc * 32 + 8 * fq;
#pragma unroll
        for (int ai = 0; ai < 2; ++ai)
#pragma unroll
            for (int m = 0; m < 4; ++m) {
                const int row = row0 + ai * 128 + m * 16;
                const float rs = row_rs(ssq, row);
#pragma unroll
                for (int bj = 0; bj < 2; ++bj) {
                    float o[8];
#pragma unroll
                    for (int n = 0; n < 2; ++n)
#pragma unroll
                        for (int i = 0; i < 4; ++i) o[n * 4 + i] = acc[ai][bj][m][n][i] * rs;
                    const int ct = bj * 128 + cw;
                    if (pn < 2) {
#pragma unroll
                        for (int i = 0; i < 8; ++i) o[i] *= 0.08838834764831845f;
                        *(u32x4*)(Q + (size_t)row * 512 + pn * 256 + ct) = pack8(o);
                    } else if (pn < 4) { *(u32x4*)(K + (size_t)row * 512 + (pn - 2) * 256 + ct) = pack8(o);
                    } else if (pn < 8) { *(u32x4*)(V + (size_t)row * 1024 + (pn - 4) * 256 + ct) = pack8(o);
                    } else if (pn < 12) {
#pragma unroll
                        for (int i = 0; i < 8; ++i) o[i] = siluf_(o[i]);
                        *(u32x4*)(R + (size_t)row * 1024 + (pn - 8) * 256 + ct) = pack8(o);
                    } else {
                        const int c = (pn - 12) * 256 + ct;
                        const f32x4 b0 = *(const f32x4*)(b_gate + c), b1 = *(const f32x4*)(b_gate + c + 4);
                        f32x4 r0, r1;
#pragma unroll
                        for (int i = 0; i < 4; ++i) { r0[i] = -softplusf_(-(o[i] + b0[i])) * (1.0f / 16.0f); r1[i] = -softplusf_(-(o[4 + i] + b1[i])) * (1.0f / 16.0f); }
                        *(f32x4*)(LA + (size_t)row * 512 + c) = r0; *(f32x4*)(LA + (size_t)row * 512 + c + 4) = r1;
                    }
                }
            }
    }
};
struct EpiBandIn {
    static constexpr bool PERM = true, AFTER_DRAIN = false;
    const float* ssq; bf16_t* QKVb; const float* gnb; float* out;
    DI void operator()(const acc_t& acc, const pg8::Unit& u, int wr, int wc, int fr, int fq) const {
        const int row0 = u.pm * 256 + wr * 64 + fr, pn = u.pn, which = pn >> 2, head = 4 * (pn & 3) + wc;
        bf16_t* dst = QKVb + (size_t)which * M * 1024;
#pragma unroll
        for (int ai = 0; ai < 2; ++ai)
#pragma unroll
            for (int m = 0; m < 4; ++m) {
                const int row = row0 + ai * 128 + m * 16;
                const float rs = row_rs(ssq, row);
                float o[2][8]; float ss = 0.f;
#pragma unroll
                for (int bj = 0; bj < 2; ++bj)
#pragma unroll
                    for (int n = 0; n < 2; ++n)
#pragma unroll
                        for (int i = 0; i < 4; ++i) { const float v = acc[ai][bj][m][n][i] * rs; o[bj][n * 4 + i] = v; ss += v * v; }
                if (which < 2) {
                    ss += __shfl_xor(ss, 16); ss += __shfl_xor(ss, 32);
                    float hs = rsq(ss * (1.0f / 64.0f) + EPS); if (which == 0) hs *= 0.125f;
                    const float* gn = gnb + which * 64;
#pragma unroll
                    for (int bj = 0; bj < 2; ++bj) {
                        const f32x4 g0 = *(const f32x4*)(gn + bj * 32 + 8 * fq), g1 = *(const f32x4*)(gn + bj * 32 + 8 * fq + 4);
#pragma unroll
                        for (int i = 0; i < 4; ++i) { o[bj][i] *= hs * g0[i]; o[bj][4 + i] *= hs * g1[i]; }
                    }
                }
                bool has_fo = false; size_t fo_off = 0;
                if (which > 0) {
                    if (row >= MP) { has_fo = true; fo_off = O_BK_S + (size_t)(which - 1) * MS * 1024 + (size_t)(row - MP) * 1024; }
                    else { const int t = row & (SEQ - 1), b = row >> 13; if (t >= SEQ - 512) { has_fo = true; fo_off = O_BK_P + (size_t)(which - 1) * 2 * 512 * 1024 + (size_t)(b * 512 + t - (SEQ - 512)) * 1024; } }
                }
                float* fo = out + fo_off;
#pragma unroll
                for (int bj = 0; bj < 2; ++bj) {
                    const int c = head * 64 + bj * 32 + 8 * fq;
                    *(u32x4*)(dst + (size_t)row * 1024 + c) = pack8(o[bj]);
                    if (has_fo) { *(f32x4*)(fo + c) = (f32x4){o[bj][0], o[bj][1], o[bj][2], o[bj][3]}; *(f32x4*)(fo + c + 4) = (f32x4){o[bj][4], o[bj][5], o[bj][6], o[bj][7]}; }
                }
            }
    }
};
struct EpiGdnIn {
    static constexpr bool PERM = true, AFTER_DRAIN = false;
    const float* ssq; bf16_t *QKV, *GG; float* BG; const float *a_log, *dt_bias; float *ocp, *ocs;
    DI void operator()(const acc_t& acc, const pg8::Unit& u, int wr, int wc, int fr, int fq) const {
        const int row0 = u.pm * 256 + wr * 64 + fr, pn = u.pn, cw = wc * 32 + 8 * fq;
#pragma unroll
        for (int ai = 0; ai < 2; ++ai)
#pragma unroll
            for (int m = 0; m < 4; ++m) {
                const int row = row0 + ai * 128 + m * 16;
                const float rs = row_rs(ssq, row);
                float* fo = nullptr;
                if (row >= MP) { const int t = (row - MP) & 63, b = (row - MP) >> 6; if (t >= 61) fo = ocs + (size_t)(b * 3 + t - 61) * 3072; }
                else { const int t = row & (SEQ - 1), b = row >> 13; if (t >= SEQ - 3) fo = ocp + (size_t)(b * 3 + t - (SEQ - 3)) * 3072; }
#pragma unroll
                for (int bj = 0; bj < 2; ++bj) {
                    float o[8];
#pragma unroll
                    for (int n = 0; n < 2; ++n)
#pragma unroll
                        for (int i = 0; i < 4; ++i) o[n * 4 + i] = acc[ai][bj][m][n][i] * rs;
                    const int ct = bj * 128 + cw;
                    if (pn < 12) {
                        const int c = pn * 256 + ct;
                        *(u32x4*)(QKV + (size_t)row * 3072 + c) = pack8(o);
                        if (fo) { *(f32x4*)(fo + c) = (f32x4){o[0], o[1], o[2], o[3]}; *(f32x4*)(fo + c + 4) = (f32x4){o[4], o[5], o[6], o[7]}; }
                    } else if (pn < 16) {
#pragma unroll
                        for (int i = 0; i < 8; ++i) o[i] = siluf_(o[i]);
                        *(u32x4*)(GG + (size_t)row * 1024 + (pn - 12) * 256 + ct) = pack8(o);
                    } else if (ct < 16) {
                        float r[8];
                        if (ct == 0) {
#pragma unroll
                            for (int i = 0; i < 8; ++i) r[i] = sigmoidf_(o[i]);
                        } else {
#pragma unroll
                            for (int i = 0; i < 8; ++i) r[i] = -fast_exp(a_log[i]) * softplusf_(o[i] + dt_bias[i]);
                        }
                        *(f32x4*)(BG + (size_t)row * 16 + ct) = (f32x4){r[0], r[1], r[2], r[3]}; *(f32x4*)(BG + (size_t)row * 16 + ct + 4) = (f32x4){r[4], r[5], r[6], r[7]};
                    }
                }
            }
    }
};
struct EpiSbIn {
    static constexpr bool PERM = true, AFTER_DRAIN = false;
    const float* ssq; bf16_t* QKVb; float* okv;
    DI void operator()(const acc_t& acc, const pg8::Unit& u, int wr, int wc, int fr, int fq) const {
        const int row0 = u.pm * 256 + wr * 64 + fr, pn = u.pn, which = pn >> 2, cw = (pn & 3) * 256 + wc * 32 + 8 * fq;
        bf16_t* dst = QKVb + (size_t)which * M * 1024;
#pragma unroll
        for (int ai = 0; ai < 2; ++ai)
#pragma unroll
            for (int m = 0; m < 4; ++m) {
                const int row = row0 + ai * 128 + m * 16;
                float rs = row_rs(ssq, row); if (which == 0) rs *= 0.125f;
                const size_t fo_off = (row >= MP) ? (size_t)2 * MP * 1024 + (size_t)(which - 1) * MS * 1024 + (size_t)(row - MP) * 1024 : (size_t)(which - 1) * MP * 1024 + (size_t)row * 1024;
                float* fo = okv + fo_off;
#pragma unroll
                for (int bj = 0; bj < 2; ++bj) {
                    float o[8];
#pragma unroll
                    for (int n = 0; n < 2; ++n)
#pragma unroll
                        for (int i = 0; i < 4; ++i) o[n * 4 + i] = acc[ai][bj][m][n][i] * rs;
                    const int c = cw + bj * 128;
                    *(u32x4*)(dst + (size_t)row * 1024 + c) = pack8(o);
                    if (which > 0) { *(f32x4*)(fo + c) = (f32x4){o[0], o[1], o[2], o[3]}; *(f32x4*)(fo + c + 4) = (f32x4){o[4], o[5], o[6], o[7]}; }
                }
            }
    }
};


struct Job { const float* src; const float* gain; const float* aux; bf16_t* dst; int K, srcN, dstN, map; };
DI void get_job(const Args& a, int j, Job& o) {
    unsigned char* ws = a.ws; o.aux = nullptr; o.gain = nullptr; o.map = 0;
    if (j < 16) {
        const int l = j >> 2, kind = j & 3;
        bf16_t* base = (bf16_t*)(ws + WS_WFFN + (size_t)l * SZ_WFFN_L);
        if (kind == 0)      { o.src = a.in[10] + (size_t)l * D * 2 * FF; o.gain = a.in[9] + l * D;  o.dst = base; o.K = D; o.srcN = 2 * FF; o.dstN = 2 * FF; o.map = 1; }
        else if (kind == 1) { o.src = a.in[11] + (size_t)l * FF * D; o.dst = base + (size_t)2 * FF * D; o.K = FF; o.srcN = D; o.dstN = D; }
        else if (kind == 2) { o.src = a.in[14] + (size_t)l * D * 2 * FF; o.gain = a.in[13] + l * D; o.dst = base + (size_t)3 * FF * D; o.K = D; o.srcN = 2 * FF; o.dstN = 2 * FF; o.map = 1; }
        else                { o.src = a.in[15] + (size_t)l * FF * D; o.dst = base + (size_t)5 * FF * D; o.K = FF; o.srcN = D; o.dstN = D; }
        return;
    }
    o.K = D; o.srcN = D; o.dstN = D;
    switch (j) {
        case 16: o.src = a.in[16]; o.gain = a.in[12];         o.aux = a.in[17]; o.dst = (bf16_t*)(ws + WS_WGLA_IN); o.srcN = 3088; o.dstN = 3584; o.map = 3; break;
        case 17: o.src = a.in[20]; o.dst = (bf16_t*)(ws + WS_WGLA_OUT); break;
        case 18: o.src = a.in[21]; o.gain = a.in[12] + D;     o.dst = (bf16_t*)(ws + WS_WBAND_IN); o.srcN = 3072; o.dstN = 3072; o.map = 2; break;
        case 19: o.src = a.in[25]; o.dst = (bf16_t*)(ws + WS_WBAND_OUT); break;
        case 20: o.src = a.in[26]; o.gain = a.in[12] + 2 * D; o.dst = (bf16_t*)(ws + WS_WGDN_IN); o.srcN = 4112; o.dstN = 4352; o.map = 4; break;
        case 21: o.src = a.in[31]; o.dst = (bf16_t*)(ws + WS_WGDN_OUT); break;
        case 22: o.src = a.in[32]; o.gain = a.in[12] + 3 * D; o.dst = (bf16_t*)(ws + WS_WSB_IN); o.srcN = 3072; o.dstN = 3072; break;
        default: o.src = a.in[33]; o.dst = (bf16_t*)(ws + WS_WSB_OUT); break;
    }
}
DI int src_col(int map, int n0) {
    if (map == 1) { const int pn = n0 >> 8, s = n0 & 255; return s < 128 ? 128 * pn + s : FF + 128 * pn + (s - 128); }
    if (map == 2) { const int pn = n0 >> 8, s = n0 & 255, bj = s >> 7, wc = (s & 127) >> 5; return (pn >> 2) * 1024 + (4 * (pn & 3) + wc) * 64 + 32 * bj; }
    if (map == 3) return n0 < 3072 ? n0 : -2;
    if (map == 4) return n0 < 4096 ? n0 : (n0 == 4096 ? -3 : -1);
    return n0;
}
DI void transpose_item(const Job& J, LAS float* scr, int item, int lane) {
    const int nblk = J.dstN >> 5, kb = item / nblk, nb = item - kb * nblk, k0 = 64 * kb, n0 = 32 * nb;
    const int sc = src_col(J.map, n0);
    const int nl = lane & 31;
#pragma unroll 4
    for (int i = 0; i < 32; ++i) {
        const int kk = 2 * i + (lane >> 5), k = k0 + kk; float v = 0.f;
        if (sc >= 0) v = J.src[(size_t)k * J.srcN + sc + nl];
        else if (sc == -3) { if (nl < 16) v = J.src[(size_t)k * J.srcN + 4096 + nl]; }
        else if (sc == -2) {
            const float* wr_ = J.src + (size_t)k * J.srcN + 3072; const float* g2 = J.aux + (n0 - 3072) + nl;
#pragma unroll
            for (int r = 0; r < 16; ++r) v += wr_[r] * g2[r * 512];
        }
        if (J.gain) v *= J.gain[k];
        scr[kk * 33 + nl] = v;
    }
    asm volatile("s_waitcnt lgkmcnt(0)" ::: "memory");
    const int c = lane & 7;
#pragma unroll
    for (int j = 0; j < 4; ++j) { const int n = (lane >> 3) + 8 * j; const LAS float* s = scr + (8 * c) * 33 + n;
        u32x4 o; o.x = pk_bf16(s[0 * 33], s[1 * 33]); o.y = pk_bf16(s[2 * 33], s[3 * 33]); o.z = pk_bf16(s[4 * 33], s[5 * 33]); o.w = pk_bf16(s[6 * 33], s[7 * 33]);
        *(u32x4*)(J.dst + (size_t)(n0 + n) * J.K + k0 + 8 * c) = o; }
    asm volatile("s_waitcnt lgkmcnt(0)" ::: "memory");
}
DI void phase_prologue(const Args& a, LAS unsigned char* lds, int G, int bx) {
    const int tid = otid(), lane = tid & 63, wave = tid >> 6;
    LAS float* scr = (LAS float*)(lds + wave * 16384);
    const int gw = bx * 8 + wave, NGW = G * 8;
    for (int j = 0; j < 24; ++j) {
        Job J; get_job(a, j, J);
        const int nitems = (J.K >> 6) * (J.dstN >> 5);
        for (int it = gw; it < nitems; it += NGW) transpose_item(J, scr, it, lane);
    }
    if (bx == 0 && tid < 128) ((float*)(a.ws + WS_GNB))[tid] = tid < 64 ? a.in[22][tid] : a.in[23][tid - 64];
    float* X = a.out; bf16_t* XB = (bf16_t*)(a.ws + WS_XB); float* ssq0 = (float*)(a.ws + WS_SSQ);
    for (int m = gw; m < M; m += NGW) {
        const float* src = m < MP ? a.in[0] + (size_t)m * D : a.in[1] + (size_t)(m - MP) * D;
        float s = 0.f;
#pragma unroll
        for (int j = 0; j < 4; ++j) {
            const f32x4 v = *(const f32x4*)(src + 256 * j + 4 * lane);
            *(f32x4*)(X + (size_t)m * D + 256 * j + 4 * lane) = v;
            u32x2 w; w.x = pk_bf16(v[0], v[1]); w.y = pk_bf16(v[2], v[3]); *(u32x2*)(XB + (size_t)m * D + 256 * j + 4 * lane) = w;
            s += (v[0] * v[0] + v[1] * v[1]) + (v[2] * v[2] + v[3] * v[3]);
        }
        s = wave_sum(s);
        if (lane < 16) ssq0[(size_t)m * 16 + lane] = lane == 0 ? s : 0.f;
    }
}


constexpr int GLA_UNITS = 288 * 4;
constexpr int S128 = 288;
constexpr int S256 = 544;
constexpr int S64 = 160;

DI void gla_load_cumsum(LAS float* LA, const float* la_g, int row0, int h, int tid) {
#pragma unroll
    for (int i = 0; i < 4; ++i) { const int q = tid + i * NT, t = q >> 5, c4 = (q & 31) * 4;
        *(LAS f32x4*)(LA + t * 128 + c4) = *(const f32x4*)(la_g + (size_t)(row0 + t) * 512 + h * 128 + c4); }
    __syncthreads();
    if (tid < 128) { float run = 0.f;
#pragma unroll 8
        for (int t = 0; t < 64; ++t) { run += LA[t * 128 + tid]; LA[t * 128 + tid] = run; } }
    __syncthreads();
}
DI void gla_load_v(LAS unsigned char* VV, const bf16_t* Vg, int row0, int h, int tid) {
#pragma unroll
    for (int i = 0; i < 4; ++i) { const int q = tid + i * NT, t = q >> 5, c8 = (q & 31) * 8;
        *(LAS u32x4*)(VV + t * S256 + c8 * 2) = *(const u32x4*)(Vg + (size_t)(row0 + t) * 1024 + h * 256 + c8); }
}
DI void phase_gla_g1(const Args& a, LAS unsigned char* lds, int G, int bx) {
    const int tid = otid(), lane = tid & 63, wave = tid >> 6, i16 = lane & 15, quad = lane >> 4;
    LAS float* LA = (LAS float*)lds; LAS unsigned char* KL = lds + 32768; LAS unsigned char* VV = lds + 32768 + 64 * S128;
    const bf16_t* Kg = (const bf16_t*)(a.ws + GLA_K); const bf16_t* Vg = (const bf16_t*)(a.ws + GLA_V); const float* la_g = (const float*)(a.ws + GLA_LA);
    float* UT = (float*)(a.ws + GLA_UT); float* DL = (float*)(a.ws + GLA_DL);
    for (int uid = bx; uid < GLA_UNITS; uid += G) {
        const int cr = uid >> 2, h = uid & 3, row0 = cr * 64;
        gla_load_v(VV, Vg, row0, h, tid);
        gla_load_cumsum(LA, la_g, row0, h, tid);
#pragma unroll
        for (int i = 0; i < 2; ++i) { const int q = tid + i * NT, t = q >> 4, c8 = (q & 15) * 8;
            float kf[8]; unpack8(*(const u32x4*)(Kg + (size_t)(row0 + t) * 512 + h * 128 + c8), kf);
#pragma unroll
            for (int e = 0; e < 8; ++e) kf[e] *= fast_exp(LA[63 * 128 + c8 + e] - LA[t * 128 + c8 + e]);
            *(LAS u32x4*)(KL + t * S128 + c8 * 2) = pack8(kf); }
        if (tid < 128) DL[(size_t)uid * 128 + tid] = fast_exp(LA[63 * 128 + tid]);
        __syncthreads();
        f32x4 acc[2][8];
#pragma unroll
        for (int x = 0; x < 2; ++x)
#pragma unroll
            for (int y = 0; y < 8; ++y) acc[x][y] = (f32x4){0.f, 0.f, 0.f, 0.f};
#pragma unroll
        for (int s = 0; s < 2; ++s) {
            const int r0 = 32 * s + 4 * quad + (i16 >> 2);
            bf16x8 Af[2];
#pragma unroll
            for (int x = 0; x < 2; ++x) { const LAS unsigned char* p = VV + r0 * S256 + (16 * (2 * wave + x)) * 2 + 8 * (i16 & 3); Af[x] = trfrag(p, p + 16 * S256); }
#pragma unroll
            for (int y = 0; y < 8; ++y) { const LAS unsigned char* p = KL + r0 * S128 + (16 * y) * 2 + 8 * (i16 & 3); const bf16x8 Bf = trfrag(p, p + 16 * S128);
#pragma unroll
                for (int x = 0; x < 2; ++x) acc[x][y] = MFMA16(Af[x], Bf, acc[x][y]); }
        }
#pragma unroll
        for (int x = 0; x < 2; ++x)
#pragma unroll
            for (int y = 0; y < 8; ++y)
#pragma unroll
                for (int jj = 0; jj < 4; ++jj) UT[(size_t)uid * 32768 + (size_t)(16 * (2 * wave + x) + 4 * quad + jj) * 128 + 16 * y + i16] = acc[x][y][jj];
        __syncthreads();
    }
}
DI void phase_gla_g2(const Args& a, int G, int bx) {
    const float* UT = (const float*)(a.ws + GLA_UT); const float* DL = (const float*)(a.ws + GLA_DL); bf16_t* ST = (bf16_t*)(a.ws + GLA_ST);
    const int nthr = G * NT; const int total = 65536 + 1048576;
    for (int it = bx * NT + otid(); it < total; it += nthr) {
        if (it < 65536) {
            const int chain = it >> 13, e4 = it & 8191, dv = e4 >> 5, dk4 = (e4 & 31) * 4, b = chain >> 2, h = chain & 3;
            f32x4 S = {0.f, 0.f, 0.f, 0.f};
#pragma unroll 4
            for (int c = 0; c < 128; ++c) {
                const int uid = ((b * 128 + c) << 2) | h; const size_t base = (size_t)uid * 32768 + dv * 128 + dk4;
                u32x2 w; w.x = pk_bf16(S[0], S[1]); w.y = pk_bf16(S[2], S[3]); *(u32x2*)(ST + base) = w;
                const f32x4 dl = *(const f32x4*)(DL + (size_t)uid * 128 + dk4); const f32x4 uu = *(const f32x4*)(UT + base);
                S = dl * S + uu;
            }
            float* o = a.out + O_GLA_P + (size_t)((b * 4 + h) * 128 + dk4) * 256 + dv;
#pragma unroll
            for (int i = 0; i < 4; ++i) o[i * 256] = S[i];
        } else {
            const int e = it - 65536, chain = e >> 13, e4 = e & 8191, dv = e4 >> 5, dk4 = (e4 & 31) * 4, bs = chain >> 2, h = chain & 3;
            const int uid = ((256 + bs) << 2) | h; const size_t base = (size_t)uid * 32768 + dv * 128 + dk4;
            const size_t so = (size_t)((bs * 4 + h) * 128 + dk4) * 256 + dv;
            f32x4 S;
#pragma unroll
            for (int i = 0; i < 4; ++i) S[i] = a.in[2][so + i * 256];
            u32x2 w; w.x = pk_bf16(S[0], S[1]); w.y = pk_bf16(S[2], S[3]); *(u32x2*)(ST + base) = w;
            const f32x4 dl = *(const f32x4*)(DL + (size_t)uid * 128 + dk4); const f32x4 uu = *(const f32x4*)(UT + base);
            S = dl * S + uu;
#pragma unroll
            for (int i = 0; i < 4; ++i) a.out[O_GLA_S + so + i * 256] = S[i];
        }
    }
}
DI void phase_gla_g3(const Args& a, LAS unsigned char* lds, int G, int bx) {
    const int tid = otid(), lane = tid & 63, wave = tid >> 6, i16 = lane & 15, quad = lane >> 4;
    LAS float* LA = (LAS float*)lds; LAS unsigned char* QE = lds + 32768; LAS unsigned char* KE = QE + 64 * S128; LAS unsigned char* VV = KE + 64 * S128;
    LAS float* XCH = (LAS float*)(VV + 64 * S256);
    const bf16_t* Qg = (const bf16_t*)(a.ws + GLA_Q); const bf16_t* Kg = (const bf16_t*)(a.ws + GLA_K); const bf16_t* Vg = (const bf16_t*)(a.ws + GLA_V);
    const bf16_t* Rg = (const bf16_t*)(a.ws + GLA_R); const float* la_g = (const float*)(a.ws + GLA_LA); const bf16_t* ST = (const bf16_t*)(a.ws + GLA_ST);
    bf16_t* OB = (bf16_t*)(a.ws + WS_OB); const float* onorm = a.in[19];
    const int ib = wave & 3, dh = wave >> 2;
    for (int uid = bx; uid < GLA_UNITS; uid += G) {
        const int cr = uid >> 2, h = uid & 3, row0 = cr * 64;
        gla_load_v(VV, Vg, row0, h, tid);
        gla_load_cumsum(LA, la_g, row0, h, tid);
#pragma unroll
        for (int i = 0; i < 2; ++i) { const int q = tid + i * NT, t = q >> 4, c8 = (q & 15) * 8;
            float qf[8], kf[8]; unpack8(*(const u32x4*)(Qg + (size_t)(row0 + t) * 512 + h * 128 + c8), qf); unpack8(*(const u32x4*)(Kg + (size_t)(row0 + t) * 512 + h * 128 + c8), kf);
#pragma unroll
            for (int e = 0; e < 8; ++e) { const float bb = LA[t * 128 + c8 + e]; qf[e] *= fast_exp(bb); kf[e] *= fast_exp(-bb); }
            *(LAS u32x4*)(QE + t * S128 + c8 * 2) = pack8(qf); *(LAS u32x4*)(KE + t * S128 + c8 * 2) = pack8(kf); }
        __syncthreads();
        bf16x8 Bq[4];
#pragma unroll
        for (int s = 0; s < 4; ++s) Bq[s] = ldfrag_l(QE + (16 * ib + i16) * S128 + (32 * s + 8 * quad) * 2);
        f32x4 at[4];
#pragma unroll
        for (int jb = 0; jb < 4; ++jb) {
            f32x4 c = {0.f, 0.f, 0.f, 0.f};
            if (jb <= ib) {
#pragma unroll
                for (int s = 0; s < 4; ++s) c = MFMA16(ldfrag_l(KE + (16 * jb + i16) * S128 + (32 * s + 8 * quad) * 2), Bq[s], c);
                if (jb == ib) {
#pragma unroll
                    for (int jj = 0; jj < 4; ++jj) if (4 * quad + jj > i16) c[jj] = 0.f;
                }
            }
            at[jb] = c;
        }
        const bf16x8 Pf0 = packfrag(at[0], at[1]), Pf1 = packfrag(at[2], at[3]);
        f32x4 o[8]; float ss = 0.f;
#pragma unroll
        for (int dvt = 0; dvt < 8; ++dvt) {
            const int dvb = 8 * dh + dvt; f32x4 c = {0.f, 0.f, 0.f, 0.f};
            { const LAS unsigned char* p = VV + (4 * quad + (i16 >> 2)) * S256 + (16 * dvb) * 2 + 8 * (i16 & 3);
              c = MFMA16(trfrag(p, p + 16 * S256), Pf0, c);
              if (ib >= 2) c = MFMA16(trfrag(p + 32 * S256, p + 48 * S256), Pf1, c); }
            const bf16_t* sp = ST + (size_t)uid * 32768 + (size_t)(16 * dvb + i16) * 128 + 8 * quad;
#pragma unroll
            for (int s = 0; s < 4; ++s) c = MFMA16(ldfrag_g(sp + 32 * s), Bq[s], c);
            o[dvt] = c; ss += (c[0] * c[0] + c[1] * c[1]) + (c[2] * c[2] + c[3] * c[3]);
        }
        ss += __shfl_xor(ss, 16); ss += __shfl_xor(ss, 32);
        if (quad == 0) XCH[dh * 64 + 16 * ib + i16] = ss;
        __syncthreads();
        const float rstd = rsq((XCH[16 * ib + i16] + XCH[64 + 16 * ib + i16]) * (1.0f / 256.0f) + EPS);
        const int row = row0 + 16 * ib + i16;
#pragma unroll
        for (int dvt = 0; dvt < 8; ++dvt) {
            const int dv0 = 16 * (8 * dh + dvt) + 4 * quad;
            const f32x4 g = *(const f32x4*)(onorm + dv0); const u32x2 rr = *(const u32x2*)(Rg + (size_t)row * 1024 + h * 256 + dv0);
            u32x2 w; w.x = pk_bf16(o[dvt][0] * rstd * g[0] * bf_lo(rr.x), o[dvt][1] * rstd * g[1] * bf_hi(rr.x));
            w.y = pk_bf16(o[dvt][2] * rstd * g[2] * bf_lo(rr.y), o[dvt][3] * rstd * g[3] * bf_hi(rr.y));
            *(u32x2*)(OB + (size_t)row * 1024 + h * 256 + dv0) = w;
        }
        __syncthreads();
    }
}


constexpr int AT_KT = 0, AT_VT = 64 * S128, AT_BIAS = 2 * 64 * S128;
DI void stage_bf16(LAS unsigned char* dst, const bf16_t* src, int tid) {
#pragma unroll
    for (int i = 0; i < 2; ++i) { const int q = tid + i * NT, r = q >> 4, c8 = (q & 15) * 8;
        *(LAS u32x4*)(dst + r * S128 + c8 * 2) = *(const u32x4*)(src + (size_t)r * 1024 + c8); }
}
DI void stage_f32(LAS unsigned char* dst, const float* src, int tid) {
#pragma unroll
    for (int i = 0; i < 2; ++i) { const int q = tid + i * NT, r = q >> 4, c8 = (q & 15) * 8;
        const f32x4 v0 = *(const f32x4*)(src + (size_t)r * 1024 + c8), v1 = *(const f32x4*)(src + (size_t)r * 1024 + c8 + 4);
        u32x4 w; w.x = pk_bf16(v0[0], v0[1]); w.y = pk_bf16(v0[2], v0[3]); w.z = pk_bf16(v1[0], v1[1]); w.w = pk_bf16(v1[2], v1[3]);
        *(LAS u32x4*)(dst + r * S128 + c8 * 2) = w; }
}
DI void qk_tiles(f32x4 (&zt)[4], const LAS unsigned char* KT, const bf16x8 (&Bq)[2], int hh, int i16, int quad) {
#pragma unroll
    for (int jb = 0; jb < 4; ++jb) { f32x4 c = {0.f, 0.f, 0.f, 0.f};
#pragma unroll
        for (int s = 0; s < 2; ++s) c = MFMA16(ldfrag_l(KT + (16 * jb + i16) * S128 + (hh * 64 + 32 * s + 8 * quad) * 2), Bq[s], c);
        zt[jb] = c; }
}
DI void pv_tiles(f32x4 (&o)[4], const LAS unsigned char* VT, const f32x4 (&pt)[4], int hh, int i16, int quad) {
    const bf16x8 P0 = packfrag(pt[0], pt[1]), P1 = packfrag(pt[2], pt[3]);
#pragma unroll
    for (int db = 0; db < 4; ++db) { const LAS unsigned char* p = VT + (4 * quad + (i16 >> 2)) * S128 + (hh * 64 + 16 * db) * 2 + 8 * (i16 & 3);
        o[db] = MFMA16(trfrag(p, p + 16 * S128), P0, o[db]); o[db] = MFMA16(trfrag(p + 32 * S128, p + 48 * S128), P1, o[db]); }
}
DI void phase_band(const Args& a, LAS unsigned char* lds, int G, int bx) {
    const int tid = otid(), lane = tid & 63, wave = __builtin_amdgcn_readfirstlane(tid >> 6), i16 = lane & 15, quad = lane >> 4, hh = wave >> 2, ib = wave & 3;
    LAS unsigned char* KT = lds + AT_KT; LAS unsigned char* VT = lds + AT_VT; LAS float* BIAS = (LAS float*)(lds + AT_BIAS);
    const bf16_t* Qg = (const bf16_t*)(a.ws + AT_Q); const bf16_t* Kg = (const bf16_t*)(a.ws + AT_K); const bf16_t* Vg = (const bf16_t*)(a.ws + AT_V);
    bf16_t* OB = (bf16_t*)(a.ws + WS_OB); const float* rel_bias = a.in[24];
    for (int uid = bx; uid < 2304; uid += G) {
        int hp, qrow0, c = 8, bs = 0, brow0 = 0; const bool samp = uid >= 2048;
        if (!samp) { hp = uid & 7; const int bc = uid >> 3; c = bc & 127; const int b = bc >> 7; brow0 = b * SEQ; qrow0 = brow0 + 64 * c; }
        else { const int u2 = uid - 2048; hp = u2 & 7; bs = u2 >> 3; qrow0 = MP + 64 * bs; }
        __syncthreads();
        for (int q = tid; q < 1026; q += NT) { const int hsel = q >= 513, idx = q - 513 * hsel; BIAS[hsel * 516 + idx] = rel_bias[(2 * hp + hsel) * 513 + idx]; }
        bf16x8 Bq[2];
#pragma unroll
        for (int s = 0; s < 2; ++s) Bq[s] = ldfrag_g(Qg + (size_t)(qrow0 + 16 * ib + i16) * 1024 + (2 * hp + hh) * 64 + 32 * s + 8 * quad);
        float mrun = -INFINITY, lrun = 0.f; f32x4 o[4];
#pragma unroll
        for (int db = 0; db < 4; ++db) o[db] = (f32x4){0.f, 0.f, 0.f, 0.f};
        const int T0 = (!samp && c < 8) ? 8 - c : 0;
        for (int T = T0; T < 9; ++T) {
            __syncthreads();
            if (samp && T < 8) { stage_f32(KT, a.in[3] + ((size_t)bs * 512 + 64 * T) * 1024 + hp * 128, tid); stage_f32(VT, a.in[4] + ((size_t)bs * 512 + 64 * T) * 1024 + hp * 128, tid); }
            else { const size_t kr = samp ? (size_t)qrow0 : (size_t)(brow0 + 64 * (c - 8 + T)); stage_bf16(KT, Kg + kr * 1024 + hp * 128, tid); stage_bf16(VT, Vg + kr * 1024 + hp * 128, tid); }
            __syncthreads();
            f32x4 zt[4]; qk_tiles(zt, KT, Bq, hh, i16, quad);
            float tmax = -INFINITY;
#pragma unroll
            for (int jb = 0; jb < 4; ++jb)
#pragma unroll
                for (int jj = 0; jj < 4; ++jj) { int idx = 768 - 64 * T + (16 * ib + i16) - (16 * jb + 4 * quad + jj); idx = idx < 0 ? 0 : (idx > 512 ? 512 : idx);
                    const float s = zt[jb][jj] + BIAS[hh * 516 + idx]; zt[jb][jj] = s; tmax = fmaxf(tmax, s); }
            tmax = fmaxf(tmax, __shfl_xor(tmax, 16)); tmax = fmaxf(tmax, __shfl_xor(tmax, 32));
            const float mnew = fmaxf(mrun, tmax), sc = fast_exp(mrun - mnew); float psum = 0.f;
#pragma unroll
            for (int jb = 0; jb < 4; ++jb)
#pragma unroll
                for (int jj = 0; jj < 4; ++jj) { const float p = fast_exp(zt[jb][jj] - mnew); zt[jb][jj] = p; psum += p; }
            lrun = lrun * sc + psum; mrun = mnew;
#pragma unroll
            for (int db = 0; db < 4; ++db) o[db] = o[db] * sc;
            pv_tiles(o, VT, zt, hh, i16, quad);
        }
        lrun += __shfl_xor(lrun, 16); lrun += __shfl_xor(lrun, 32);
        const float inv = 1.0f / lrun; const int row = qrow0 + 16 * ib + i16;
#pragma unroll
        for (int db = 0; db < 4; ++db) { u32x2 w; w.x = pk_bf16(o[db][0] * inv, o[db][1] * inv); w.y = pk_bf16(o[db][2] * inv, o[db][3] * inv);
            *(u32x2*)(OB + (size_t)row * 1024 + (2 * hp + hh) * 64 + 16 * db + 4 * quad) = w; }
    }
}
constexpr float SB_STOP = 80.0f;
DI void phase_sb(const Args& a, LAS unsigned char* lds, int G, int bx) {
    const int tid = otid(), lane = tid & 63, wave = __builtin_amdgcn_readfirstlane(tid >> 6), i16 = lane & 15, quad = lane >> 4, hh = wave >> 2, ib = wave & 3;
    LAS unsigned char* KT = lds + AT_KT; LAS unsigned char* VT = lds + AT_VT; LAS unsigned* FL = (LAS unsigned*)(lds + AT_BIAS);
    const bf16_t* Qg = (const bf16_t*)(a.ws + AT_Q); const bf16_t* Kg = (const bf16_t*)(a.ws + AT_K); const bf16_t* Vg = (const bf16_t*)(a.ws + AT_V);
    bf16_t* OB = (bf16_t*)(a.ws + WS_OB);
    for (int uid = bx; uid < 2304; uid += G) {
        int hp, qrow0, ntile, bs = 0, brow0 = 0, qblk = 0; const bool samp = uid >= 2048;
        if (!samp) { hp = uid & 7; const int bq = uid >> 3; qblk = 127 - (bq & 127); const int b = bq >> 7; brow0 = b * SEQ; qrow0 = brow0 + 64 * qblk; ntile = qblk + 1; }
        else { const int u2 = uid - 2048; hp = u2 & 7; bs = u2 >> 3; qrow0 = MP + 64 * bs; ntile = 65; }
        bf16x8 Bq[2];
#pragma unroll
        for (int s = 0; s < 2; ++s) Bq[s] = ldfrag_g(Qg + (size_t)(qrow0 + 16 * ib + i16) * 1024 + (2 * hp + hh) * 64 + 32 * s + 8 * quad);
        float carry = 0.f; f32x4 o[4]; bool wdone = false;
#pragma unroll
        for (int db = 0; db < 4; ++db) o[db] = (f32x4){0.f, 0.f, 0.f, 0.f};
        for (int it = 0; it < ntile; ++it) {
            __syncthreads();
            if (it > 0) { const u32x4 f0 = *(const LAS u32x4*)FL, f1 = *(const LAS u32x4*)(FL + 4); if ((f0.x & f0.y & f0.z & f0.w & f1.x & f1.y & f1.z & f1.w) != 0u) break; }
            if (samp && it > 0) { const size_t r = (size_t)bs * 4096 + 64 * (64 - it); stage_f32(KT, a.in[7] + r * 1024 + hp * 128, tid); stage_f32(VT, a.in[8] + r * 1024 + hp * 128, tid); }
            else { const size_t kr = samp ? (size_t)qrow0 : (size_t)(brow0 + 64 * (qblk - it)); stage_bf16(KT, Kg + kr * 1024 + hp * 128, tid); stage_bf16(VT, Vg + kr * 1024 + hp * 128, tid); }
            __syncthreads();
            if (!wdone) {
                f32x4 zt[4]; qk_tiles(zt, KT, Bq, hh, i16, quad);
                f32x4 sp[4]; float g[4];
#pragma unroll
                for (int jb = 0; jb < 4; ++jb) {
#pragma unroll
                    for (int jj = 0; jj < 4; ++jj) { const bool valid = (it > 0) || (16 * jb + 4 * quad + jj < 16 * ib + i16); sp[jb][jj] = valid ? softplusf_(zt[jb][jj]) : 0.f; if (!valid) zt[jb][jj] = -INFINITY; }
                    sp[jb][2] += sp[jb][3]; sp[jb][1] += sp[jb][2]; sp[jb][0] += sp[jb][1]; g[jb] = sp[jb][0];
                }
                float run = carry;
#pragma unroll
                for (int jb = 3; jb >= 0; --jb) {
                    const float x1 = __shfl_xor(g[jb], 16), x2 = __shfl_xor(g[jb], 32), x3 = __shfl_xor(g[jb], 48);
                    const float above = ((quad ^ 1) > quad ? x1 : 0.f) + ((quad ^ 2) > quad ? x2 : 0.f) + ((quad ^ 3) > quad ? x3 : 0.f);
                    const float off = run + above;
#pragma unroll
                    for (int jj = 0; jj < 4; ++jj) zt[jb][jj] = fast_exp(zt[jb][jj] - (off + sp[jb][jj]));
                    run += (g[jb] + x1) + (x2 + x3);
                }
                carry = run;
                pv_tiles(o, VT, zt, hh, i16, quad);
                wdone = __all(carry > SB_STOP);
            }
            if (lane == 0) FL[wave] = wdone ? 1u : 0u;
        }
        const int row = qrow0 + 16 * ib + i16;
#pragma unroll
        for (int db = 0; db < 4; ++db) { u32x2 w; w.x = pk_bf16(o[db][0], o[db][1]); w.y = pk_bf16(o[db][2], o[db][3]);
            *(u32x2*)(OB + (size_t)row * 1024 + (2 * hp + hh) * 64 + 16 * db + 4 * quad) = w; }
    }
}


constexpr int GDN_UNITS = 288 * 8;
constexpr int RAWS = 784;
constexpr int D1_RAW = 0, D1_MM = 0, D1_TB = 17408, D1_QN = 52736, D1_KN = D1_QN + 64 * S128, D1_VB = D1_KN + 64 * S128, D1_KBG = D1_VB + 64 * S128, D1_SM = D1_KBG + 64 * S128;
static_assert(67 * RAWS <= D1_QN && D1_TB + 64 * S64 <= D1_QN && D1_SM + 1024 <= RING_BYTES, "GDN prep LDS map");
DI void phase_gdn_d1(const Args& a, LAS unsigned char* lds, int G, int bx) {
    const int tid = otid(), lane = tid & 63, wave = __builtin_amdgcn_readfirstlane(tid >> 6), i16 = lane & 15, quad = lane >> 4, ib = wave & 3, half = wave >> 2;
    LAS unsigned char* RAW = lds + D1_RAW; LAS float* MM = (LAS float*)(lds + D1_MM); LAS unsigned char* TB = lds + D1_TB;
    LAS unsigned char* QN = lds + D1_QN; LAS unsigned char* KN = lds + D1_KN; LAS unsigned char* VB = lds + D1_VB; LAS unsigned char* KBG = lds + D1_KBG;
    LAS float* BETA = (LAS float*)(lds + D1_SM); LAS float* GC = BETA + 64; LAS float* RNQ = BETA + 128; LAS float* RNK = BETA + 192;
    const bf16_t* QKV = (const bf16_t*)(a.ws + GDN_QKV); const float* BG = (const float*)(a.ws + GDN_BG); const float* cw = a.in[27];
    bf16_t* QE = (bf16_t*)(a.ws + GDN_QE); bf16_t* WN = (bf16_t*)(a.ws + GDN_WN); bf16_t* KLT = (bf16_t*)(a.ws + GDN_KLT); bf16_t* ATT = (bf16_t*)(a.ws + GDN_ATT);
    float* UT = (float*)(a.ws + GDN_UT); float* DLAST = (float*)(a.ws + GDN_DLAST);
    for (int uid = bx; uid < GDN_UNITS; uid += G) {
        const int cr = uid >> 3, h = uid & 7, row0 = cr * 64; const bool samp = cr >= 256; const int bs = cr - 256; const bool first = !samp && (cr & 127) == 0;
        __syncthreads();
        for (int q = tid; q < 67 * 48; q += NT) { const int r = q / 48, ch = q - r * 48, seg = ch >> 4, c8 = (ch & 15) * 8, col = seg * 1024 + h * 128 + c8;
            u32x4 w = {0u, 0u, 0u, 0u};
            if (r >= 3 || (!samp && !first)) w = *(const u32x4*)(QKV + (size_t)(row0 - 3 + r) * 3072 + col);
            else if (samp) { const float* s = a.in[6] + (size_t)(bs * 3 + r) * 3072 + col; const f32x4 v0 = *(const f32x4*)s, v1 = *(const f32x4*)(s + 4);
                w.x = pk_bf16(v0[0], v0[1]); w.y = pk_bf16(v0[2], v0[3]); w.z = pk_bf16(v1[0], v1[1]); w.w = pk_bf16(v1[2], v1[3]); }
            *(LAS u32x4*)(RAW + r * RAWS + (seg * 128 + c8) * 2) = w; }
        if (tid < 64) { BETA[tid] = BG[(size_t)(row0 + tid) * 16 + h]; float v = BG[(size_t)(row0 + tid) * 16 + 8 + h];
#pragma unroll
            for (int o = 1; o < 64; o <<= 1) { const float u = __shfl_up(v, o); if (lane >= o) v += u; }
            GC[tid] = v; }
        __syncthreads();
        for (int q = tid; q < 64 * 48; q += NT) { const int t = q / 48, ch = q - t * 48, seg = ch >> 4, c8 = (ch & 15) * 8, col = seg * 1024 + h * 128 + c8;
            float y[8] = {0.f, 0.f, 0.f, 0.f, 0.f, 0.f, 0.f, 0.f};
#pragma unroll
            for (int i = 0; i < 4; ++i) { float x[8]; unpack8(*(const LAS u32x4*)(RAW + (t + i) * RAWS + (seg * 128 + c8) * 2), x);
                const f32x4 w0 = *(const f32x4*)(cw + i * 3072 + col), w1 = *(const f32x4*)(cw + i * 3072 + col + 4);
#pragma unroll
                for (int e = 0; e < 4; ++e) { y[e] += x[e] * w0[e]; y[4 + e] += x[4 + e] * w1[e]; } }
            const float sc = seg == 2 ? BETA[t] : 1.0f;
#pragma unroll
            for (int e = 0; e < 8; ++e) y[e] = siluf_(y[e]) * sc;
            LAS unsigned char* dst = seg == 0 ? QN : (seg == 1 ? KN : VB);
            *(LAS u32x4*)(dst + t * S128 + c8 * 2) = pack8(y); }
        __syncthreads();
        if (tid < 128) { const int t = tid & 63, which = tid >> 6; const LAS unsigned char* src = (which ? KN : QN) + t * S128; float ss = 0.f;
#pragma unroll
            for (int c = 0; c < 16; ++c) { float x[8]; unpack8(*(const LAS u32x4*)(src + c * 16), x);
#pragma unroll
                for (int e = 0; e < 8; ++e) ss += x[e] * x[e]; }
            float rn = rsq(ss + EPS); if (which == 0) { rn *= 0.08838834764831845f; RNQ[t] = rn; } else RNK[t] = rn; }
        __syncthreads();
        for (int q = tid; q < 2048; q += NT) { const int which = q >> 10, r = q & 1023, t = r >> 4, c8 = (r & 15) * 8; const float eg = fast_exp(GC[t]);
            if (which == 0) { float x[8]; unpack8(*(const LAS u32x4*)(QN + t * S128 + c8 * 2), x); const float rn = RNQ[t]; float xe[8];
#pragma unroll
                for (int e = 0; e < 8; ++e) { x[e] *= rn; xe[e] = x[e] * eg; }
                *(LAS u32x4*)(QN + t * S128 + c8 * 2) = pack8(x); *(u32x4*)(QE + (size_t)uid * 8192 + t * 128 + c8) = pack8(xe);
            } else { float x[8]; unpack8(*(const LAS u32x4*)(KN + t * S128 + c8 * 2), x); const float rn = RNK[t], be = BETA[t] * eg; float xb[8];
#pragma unroll
                for (int e = 0; e < 8; ++e) { x[e] *= rn; xb[e] = x[e] * be; }
                *(LAS u32x4*)(KN + t * S128 + c8 * 2) = pack8(x); *(LAS u32x4*)(KBG + t * S128 + c8 * 2) = pack8(xb); } }
        __syncthreads();
        if (half == 0) {
            bf16x8 Af[4];
#pragma unroll
            for (int s = 0; s < 4; ++s) Af[s] = ldfrag_l(KN + (16 * ib + i16) * S128 + (32 * s + 8 * quad) * 2);
            for (int jb = 0; jb <= ib; ++jb) { f32x4 c = {0.f, 0.f, 0.f, 0.f};
#pragma unroll
                for (int s = 0; s < 4; ++s) c = MFMA16(Af[s], ldfrag_l(KN + (16 * jb + i16) * S128 + (32 * s + 8 * quad) * 2), c);
                const int j = 16 * jb + i16; const float gj = GC[j];
#pragma unroll
                for (int jj = 0; jj < 4; ++jj) { const int i = 16 * ib + 4 * quad + jj; MM[i * 68 + j] = (j < i) ? BETA[i] * c[jj] * fast_exp(GC[i] - gj) : 0.f; } }
        } else {
            bf16x8 Bf[4];
#pragma unroll
            for (int s = 0; s < 4; ++s) Bf[s] = ldfrag_l(QN + (16 * ib + i16) * S128 + (32 * s + 8 * quad) * 2);
            const int i = 16 * ib + i16; const float gi = GC[i];
            for (int jb = 0; jb < 4; ++jb) { f32x4 c = {0.f, 0.f, 0.f, 0.f};
                if (jb <= ib) {
#pragma unroll
                    for (int s = 0; s < 4; ++s) c = MFMA16(ldfrag_l(KN + (16 * jb + i16) * S128 + (32 * s + 8 * quad) * 2), Bf[s], c);
#pragma unroll
                    for (int jj = 0; jj < 4; ++jj) { const int j = 16 * jb + 4 * quad + jj; c[jj] = (j <= i) ? c[jj] * fast_exp(gi - GC[j]) : 0.f; } }
                u32x2 w; w.x = pk_bf16(c[0], c[1]); w.y = pk_bf16(c[2], c[3]);
                *(u32x2*)(ATT + (size_t)uid * 4096 + i * 64 + 16 * jb + 4 * quad) = w; }
        }
        __syncthreads();
        if (wave == 0) { float tc[64];
#pragma unroll
            for (int i = 0; i < 64; ++i) { float acc = (i == lane) ? 1.0f : 0.0f;
#pragma unroll
                for (int j = 0; j < i; ++j) acc -= MM[i * 68 + j] * tc[j];
                tc[i] = acc; }
#pragma unroll
            for (int i = 0; i < 64; ++i) *(LAS bf16_t*)(TB + i * S64 + lane * 2) = (bf16_t)(pk_bf16(tc[i], 0.f) & 0xffffu); }
        for (int q = tid; q < 1024; q += NT) { const int dk = q >> 3, to = (q & 7) * 8; const float gl = GC[63]; float x[8];
#pragma unroll
            for (int e = 0; e < 8; ++e) x[e] = bf2f(*(const LAS bf16_t*)(KN + (to + e) * S128 + dk * 2)) * fast_exp(gl - GC[to + e]);
            *(u32x4*)(KLT + (size_t)uid * 8192 + dk * 64 + to) = pack8(x); }
        if (tid == 0) DLAST[uid] = fast_exp(GC[63]);
        __syncthreads();
        { bf16x8 Tf[2];
#pragma unroll
          for (int s = 0; s < 2; ++s) Tf[s] = ldfrag_l(TB + (16 * ib + i16) * S64 + (32 * s + 8 * quad) * 2);
          const LAS unsigned char* src = half == 0 ? VB : KBG;
#pragma unroll
          for (int cb = 0; cb < 8; ++cb) { f32x4 c = {0.f, 0.f, 0.f, 0.f};
#pragma unroll
              for (int s = 0; s < 2; ++s) { const LAS unsigned char* p = src + (32 * s + 8 * quad + (i16 >> 2)) * S128 + (16 * cb) * 2 + 8 * (i16 & 3); const bf16x8 X = trfrag(p, p + 4 * S128);
                  c = (half == 0) ? MFMA16(Tf[s], X, c) : MFMA16(X, Tf[s], c); }
              if (half == 0) *(f32x4*)(UT + (size_t)uid * 8192 + (16 * cb + i16) * 64 + 16 * ib + 4 * quad) = c;
              else { u32x2 w; w.x = pk_bf16(-c[0], -c[1]); w.y = pk_bf16(-c[2], -c[3]); *(u32x2*)(WN + (size_t)uid * 8192 + (16 * ib + i16) * 128 + 16 * cb + 4 * quad) = w; } }
        }
    }
}
DI void phase_gdn_d2(const Args& a, int G, int bx) {
    const int tid = otid(), lane = tid & 63, wave = __builtin_amdgcn_readfirstlane(tid >> 6), i16 = lane & 15, quad = lane >> 4, dv = 16 * wave + i16;
    const bf16_t* WN = (const bf16_t*)(a.ws + GDN_WN); const bf16_t* KLT = (const bf16_t*)(a.ws + GDN_KLT); const float* UT = (const float*)(a.ws + GDN_UT); const float* DLAST = (const float*)(a.ws + GDN_DLAST);
    bf16_t* STB = (bf16_t*)(a.ws + GDN_STB); bf16_t* VNT = (bf16_t*)(a.ws + GDN_VNT);
    for (int item = bx; item < 16 + 256; item += G) {
        const bool samp = item >= 16; int b, h, nstep; const float* s0 = nullptr; float* sout;
        if (!samp) { b = item >> 3; h = item & 7; nstep = 128; sout = a.out + O_GDN_P + (size_t)(b * 8 + h) * 16384; }
        else { const int e = item - 16; b = e >> 3; h = e & 7; nstep = 1; s0 = a.in[5] + (size_t)(b * 8 + h) * 16384; sout = a.out + O_GDN_S + (size_t)(b * 8 + h) * 16384; }
        f32x4 S[8];
#pragma unroll
        for (int t = 0; t < 8; ++t)
#pragma unroll
            for (int jj = 0; jj < 4; ++jj) S[t][jj] = s0 ? s0[(size_t)(16 * t + 4 * quad + jj) * 128 + dv] : 0.f;
        for (int c = 0; c < nstep; ++c) {
            const int cr = samp ? 256 + b : b * 128 + c; const size_t uid = (size_t)cr * 8 + h;
            bf16x8 Sf[4];
#pragma unroll
            for (int ks = 0; ks < 4; ++ks) Sf[ks] = packfrag(S[2 * ks], S[2 * ks + 1]);
#pragma unroll
            for (int t = 0; t < 8; ++t) { u32x2 w; w.x = pk_bf16(S[t][0], S[t][1]); w.y = pk_bf16(S[t][2], S[t][3]); *(u32x2*)(STB + uid * 16384 + (size_t)dv * 128 + 16 * t + 4 * quad) = w; }
            f32x4 vn[4];
#pragma unroll
            for (int tb = 0; tb < 4; ++tb) { f32x4 cacc = *(const f32x4*)(UT + uid * 8192 + (size_t)dv * 64 + 16 * tb + 4 * quad);
                const bf16_t* wp = WN + uid * 8192 + (size_t)(16 * tb + i16) * 128 + 4 * quad;
#pragma unroll
                for (int ks = 0; ks < 4; ++ks) cacc = MFMA16(ldfrag2_g(wp + 32 * ks, wp + 32 * ks + 16), Sf[ks], cacc);
                vn[tb] = cacc;
                u32x2 w; w.x = pk_bf16(cacc[0], cacc[1]); w.y = pk_bf16(cacc[2], cacc[3]); *(u32x2*)(VNT + uid * 8192 + (size_t)dv * 64 + 16 * tb + 4 * quad) = w; }
            const bf16x8 Vf0 = packfrag(vn[0], vn[1]), Vf1 = packfrag(vn[2], vn[3]);
            const float dl = DLAST[uid];
#pragma unroll
            for (int t = 0; t < 8; ++t) { const bf16_t* kp = KLT + uid * 8192 + (size_t)(16 * t + i16) * 64 + 4 * quad;
                f32x4 cacc = S[t] * dl;
                cacc = MFMA16(ldfrag2_g(kp, kp + 16), Vf0, cacc); cacc = MFMA16(ldfrag2_g(kp + 32, kp + 48), Vf1, cacc);
                S[t] = cacc; }
        }
#pragma unroll
        for (int t = 0; t < 8; ++t)
#pragma unroll
            for (int jj = 0; jj < 4; ++jj) sout[(size_t)(16 * t + 4 * quad + jj) * 128 + dv] = S[t][jj];
    }
}
DI void phase_gdn_d3(const Args& a, LAS unsigned char* lds, int G, int bx) {
    const int tid = otid(), lane = tid & 63, wave = __builtin_amdgcn_readfirstlane(tid >> 6), i16 = lane & 15, quad = lane >> 4, tb = wave & 3, dh = wave >> 2;
    LAS float* XCH = (LAS float*)lds;
    const bf16_t* QE = (const bf16_t*)(a.ws + GDN_QE); const bf16_t* ATT = (const bf16_t*)(a.ws + GDN_ATT); const bf16_t* STB = (const bf16_t*)(a.ws + GDN_STB); const bf16_t* VNT = (const bf16_t*)(a.ws + GDN_VNT);
    const bf16_t* GG = (const bf16_t*)(a.ws + GDN_GG); bf16_t* OB = (bf16_t*)(a.ws + WS_OB); const float* onorm = a.in[30];
    for (int uid = bx; uid < GDN_UNITS; uid += G) {
        const int cr = uid >> 3, h = uid & 7, row0 = cr * 64;
        bf16x8 Bq[4], Ba[2];
#pragma unroll
        for (int s = 0; s < 4; ++s) Bq[s] = ldfrag_g(QE + (size_t)uid * 8192 + (16 * tb + i16) * 128 + 32 * s + 8 * quad);
#pragma unroll
        for (int s = 0; s < 2; ++s) Ba[s] = ldfrag_g(ATT + (size_t)uid * 4096 + (16 * tb + i16) * 64 + 32 * s + 8 * quad);
        f32x4 o[4]; float ss = 0.f;
#pragma unroll
        for (int dvt = 0; dvt < 4; ++dvt) { const int dvr = 64 * dh + 16 * dvt + i16; f32x4 c = {0.f, 0.f, 0.f, 0.f};
#pragma unroll
            for (int s = 0; s < 4; ++s) c = MFMA16(ldfrag_g(STB + (size_t)uid * 16384 + dvr * 128 + 32 * s + 8 * quad), Bq[s], c);
#pragma unroll
            for (int s = 0; s < 2; ++s) c = MFMA16(ldfrag_g(VNT + (size_t)uid * 8192 + dvr * 64 + 32 * s + 8 * quad), Ba[s], c);
            o[dvt] = c; ss += (c[0] * c[0] + c[1] * c[1]) + (c[2] * c[2] + c[3] * c[3]); }
        ss += __shfl_xor(ss, 16); ss += __shfl_xor(ss, 32);
        __syncthreads();
        if (quad == 0) XCH[dh * 64 + 16 * tb + i16] = ss;
        __syncthreads();
        const float rstd = rsq((XCH[16 * tb + i16] + XCH[64 + 16 * tb + i16]) * (1.0f / 128.0f) + EPS);
        const int row = row0 + 16 * tb + i16;
#pragma unroll
        for (int dvt = 0; dvt < 4; ++dvt) { const int dv0 = 64 * dh + 16 * dvt + 4 * quad;
            const f32x4 g = *(const f32x4*)(onorm + dv0); const u32x2 rr = *(const u32x2*)(GG + (size_t)row * 1024 + h * 128 + dv0);
            u32x2 w; w.x = pk_bf16(o[dvt][0] * rstd * g[0] * bf_lo(rr.x), o[dvt][1] * rstd * g[1] * bf_hi(rr.x));
            w.y = pk_bf16(o[dvt][2] * rstd * g[2] * bf_lo(rr.y), o[dvt][3] * rstd * g[3] * bf_hi(rr.y));
            *(u32x2*)(OB + (size_t)row * 1024 + h * 128 + dv0) = w; }
    }
}


#ifndef MK_N_LAUNCHES
#define MK_N_LAUNCHES 1
#endif
constexpr int PH_END = 1 + 16 * 3 + 9;
DI const bf16_t* wffn(const Args& a, int l, int k) { const size_t off = k == 0 ? 0 : (k == 1 ? (size_t)2 * FF * D : (k == 2 ? (size_t)3 * FF * D : (size_t)5 * FF * D)); return (const bf16_t*)(a.ws + WS_WFFN + (size_t)l * SZ_WFFN_L) + off; }
DI float* ssq_arr(const Args& a, int i) { return (float*)(a.ws + WS_SSQ) + (size_t)i * M * 16; }


enum { K_PRO = 0, K_UP1, K_DN1, K_UP2, K_DN2, K_OUT, K_GLA_IN, K_G1, K_G2, K_G3, K_BAND_IN, K_BAND, K_GDN_IN, K_D1, K_D2, K_D3, K_SB_IN, K_SB, K_NKIND };
template <int KIND> DI void run_phase(const Args& a, LAS unsigned char* lds, int G, int bx, int l) {
    float* X = a.out; bf16_t* XB = (bf16_t*)(a.ws + WS_XB); bf16_t* ACT = (bf16_t*)(a.ws + WS_ACT); bf16_t* OB = (bf16_t*)(a.ws + WS_OB);
    if constexpr (KIND == K_PRO) phase_prologue(a, lds, G, bx);
    if constexpr (KIND == K_UP1 || KIND == K_UP2) { pg8::Gemm g{XB, wffn(a, l, KIND == K_UP1 ? 0 : 2), M, 2 * FF, D}; pg8::StaticOrder S; S.init(M, 2 * FF, G, bx);
        EpiSwiglu E{ACT, ssq_arr(a, 3 * l + (KIND == K_UP1 ? 0 : 2))}; pg8::gemm_phase<EpiSwiglu, pg8::StaticOrder, true, true>(lds, g, S, E); }
    if constexpr (KIND == K_DN1 || KIND == K_DN2) { pg8::Gemm g{ACT, wffn(a, l, KIND == K_DN1 ? 1 : 3), M, D, FF}; pg8::StaticOrder S; S.init(M, D, G, bx);
        EpiResid E{X, XB, ssq_arr(a, 3 * l + (KIND == K_DN1 ? 1 : 3)), 0.5f}; pg8::gemm_phase<EpiResid, pg8::StaticOrder, true, true>(lds, g, S, E); }
    if constexpr (KIND == K_OUT) { const size_t wo = l == 0 ? WS_WGLA_OUT : (l == 1 ? WS_WBAND_OUT : (l == 2 ? WS_WGDN_OUT : WS_WSB_OUT));
        pg8::Gemm g{OB, (const bf16_t*)(a.ws + wo), M, D, D}; pg8::StaticOrder S; S.init(M, D, G, bx);
        EpiResid E{X, XB, ssq_arr(a, 3 * l + 2), 1.0f}; pg8::gemm_phase<EpiResid, pg8::StaticOrder, true, true>(lds, g, S, E); }
    if constexpr (KIND == K_GLA_IN) { pg8::Gemm g{XB, (const bf16_t*)(a.ws + WS_WGLA_IN), M, 3584, D}; pg8::StaticOrder S; S.init(M, 3584, G, bx);
        EpiGlaIn E{ssq_arr(a, 1), (bf16_t*)(a.ws + GLA_Q), (bf16_t*)(a.ws + GLA_K), (bf16_t*)(a.ws + GLA_V), (bf16_t*)(a.ws + GLA_R), (float*)(a.ws + GLA_LA), a.in[18]};
        pg8::gemm_phase<EpiGlaIn, pg8::StaticOrder, true, true>(lds, g, S, E); }
    if constexpr (KIND == K_G1) phase_gla_g1(a, lds, G, bx);
    if constexpr (KIND == K_G2) phase_gla_g2(a, G, bx);
    if constexpr (KIND == K_G3) phase_gla_g3(a, lds, G, bx);
    if constexpr (KIND == K_BAND_IN) { pg8::Gemm g{XB, (const bf16_t*)(a.ws + WS_WBAND_IN), M, 3072, D}; pg8::StaticOrder S; S.init(M, 3072, G, bx);
        EpiBandIn E{ssq_arr(a, 4), (bf16_t*)(a.ws + AT_Q), (const float*)(a.ws + WS_GNB), a.out};
        pg8::gemm_phase<EpiBandIn, pg8::StaticOrder, true, true>(lds, g, S, E); }
    if constexpr (KIND == K_BAND) phase_band(a, lds, G, bx);
    if constexpr (KIND == K_GDN_IN) { pg8::Gemm g{XB, (const bf16_t*)(a.ws + WS_WGDN_IN), M, 4352, D}; pg8::StaticOrder S; S.init(M, 4352, G, bx);
        EpiGdnIn E{ssq_arr(a, 7), (bf16_t*)(a.ws + GDN_QKV), (bf16_t*)(a.ws + GDN_GG), (float*)(a.ws + GDN_BG), a.in[28], a.in[29], a.out + O_GDNC_P, a.out + O_GDNC_S};
        pg8::gemm_phase<EpiGdnIn, pg8::StaticOrder, true, true>(lds, g, S, E); }
    if constexpr (KIND == K_D1) phase_gdn_d1(a, lds, G, bx);
    if constexpr (KIND == K_D2) phase_gdn_d2(a, G, bx);
    if constexpr (KIND == K_D3) phase_gdn_d3(a, lds, G, bx);
    if constexpr (KIND == K_SB_IN) { pg8::Gemm g{XB, (const bf16_t*)(a.ws + WS_WSB_IN), M, 3072, D}; pg8::StaticOrder S; S.init(M, 3072, G, bx);
        EpiSbIn E{ssq_arr(a, 10), (bf16_t*)(a.ws + AT_Q), a.out + O_SBK_P};
        pg8::gemm_phase<EpiSbIn, pg8::StaticOrder, true, true>(lds, g, S, E); }
    if constexpr (KIND == K_SB) phase_sb(a, lds, G, bx);
}
#if MK_N_LAUNCHES != 1
template <int KIND> __global__ void __launch_bounds__(NT, 2) k_phase(KArgs ka, int l) {
    extern __shared__ __attribute__((aligned(16))) unsigned char lds_raw[];
    LAS unsigned char* lds = (LAS unsigned char*)lds_raw;
    store_args(ka, lds); __syncthreads();
    const Args a = load_args(lds);
    run_phase<KIND>(a, lds, gridDim.x, blockIdx.x, l);
}
#else
__global__ void __launch_bounds__(NT, 2) mega(KArgs ka) {
    extern __shared__ __attribute__((aligned(16))) unsigned char lds_raw[];
    LAS unsigned char* lds = (LAS unsigned char*)lds_raw;
    const int tid = threadIdx.x, G = gridDim.x, bx = blockIdx.x;
    for (int u = tid; u < (LDS_BYTES - RING_BYTES) / 4; u += NT) ((LAS unsigned*)(lds + RING_BYTES))[u] = 0u;
    __syncthreads();
    store_args(ka, lds);
    __syncthreads();
    const XcdBarrier bar = xcd_barrier_post((unsigned*)(load_args(lds).ws + WS_CTL) + CW_BAR, (volatile LAS unsigned*)(lds + MISC_OFF) + 8);
#define PH(KIND, l) do { { const Args a = load_args(lds); run_phase<KIND>(a, lds, G, bx, l); } xcd_barrier(bar); } while (0)
    PH(K_PRO, 0);
#define LAYER_HEAD(l) PH(K_UP1, l); PH(K_DN1, l);
#define LAYER_TAIL(l) PH(K_OUT, l); PH(K_UP2, l); { const Args a = load_args(lds); run_phase<K_DN2>(a, lds, G, bx, l); }
    LAYER_HEAD(0) PH(K_GLA_IN, 0); PH(K_G1, 0); PH(K_G2, 0); PH(K_G3, 0); LAYER_TAIL(0) xcd_barrier(bar);
    LAYER_HEAD(1) PH(K_BAND_IN, 1); PH(K_BAND, 1); LAYER_TAIL(1) xcd_barrier(bar);
    LAYER_HEAD(2) PH(K_GDN_IN, 2); PH(K_D1, 2); PH(K_D2, 2); PH(K_D3, 2); LAYER_TAIL(2) xcd_barrier(bar);
    LAYER_HEAD(3) PH(K_SB_IN, 3); PH(K_SB, 3); LAYER_TAIL(3)
#undef LAYER_HEAD
#undef LAYER_TAIL
#undef PH
}
#endif

#if MK_N_LAUNCHES != 1
template <int KIND> static void launch_kind(const KArgs& a, int l, int grid, hipStream_t stream) {
    static bool attr_done = false;
    if (!attr_done) { (void)hipFuncSetAttribute((const void*)k_phase<KIND>, hipFuncAttributeMaxDynamicSharedMemorySize, LDS_BYTES); attr_done = true; }
    hipLaunchKernelGGL(k_phase<KIND>, dim3(grid), dim3(NT), LDS_BYTES, stream, a, l);
}
#endif
extern "C" void kernel_launch(void* const* d_in, const int* in_sizes, int n_in, void* d_out, int out_size, void* d_ws, size_t ws_size, hipStream_t stream) {
    static int grid = 0;
    if (grid == 0) {
        if (n_in != 34 || (size_t)out_size != O_END || ws_size < WS_END) { fprintf(stderr, "kernel_launch: unexpected shapes: n_in %d out %d ws %zu (need %zu)\n", n_in, out_size, ws_size, (size_t)WS_END); grid = -1; return; }
        int dev = 0, cus = 0;
        if (hipGetDevice(&dev) != hipSuccess || hipDeviceGetAttribute(&cus, hipDeviceAttributeMultiprocessorCount, dev) != hipSuccess) { grid = -1; return; }
#if MK_N_LAUNCHES == 1
        int per_cu = 0;
        if (hipFuncSetAttribute((const void*)mega, hipFuncAttributeMaxDynamicSharedMemorySize, LDS_BYTES) != hipSuccess) { fprintf(stderr, "kernel_launch: hipFuncSetAttribute failed\n"); grid = -1; return; }
        if (hipOccupancyMaxActiveBlocksPerMultiprocessor(&per_cu, (const void*)mega, NT, LDS_BYTES) != hipSuccess || per_cu < 1) fprintf(stderr, "kernel_launch: occupancy query reports %d\n", per_cu);
        (void)hipGetLastError();
#endif
        grid = cus;
    }
    if (grid < 0) return;
    if (hipMemsetAsync((char*)d_ws + WS_CTL, 0, CTL_ZERO_BYTES, stream) != hipSuccess) return;
    KArgs a{};
    for (int i = 0; i < 34; ++i) a.in[i] = (const float*)d_in[i];
    a.out = (float*)d_out; a.ws = (unsigned char*)d_ws;
#if MK_N_LAUNCHES == 1
    hipLaunchKernelGGL(mega, dim3(grid), dim3(NT), LDS_BYTES, stream, a);
#else
    launch_kind<K_PRO>(a, 0, grid, stream);
    for (int l = 0; l < 4; ++l) {
        launch_kind<K_UP1>(a, l, grid, stream); launch_kind<K_DN1>(a, l, grid, stream);
        if (l == 0) { launch_kind<K_GLA_IN>(a, l, grid, stream); launch_kind<K_G1>(a, l, grid, stream); launch_kind<K_G2>(a, l, grid, stream); launch_kind<K_G3>(a, l, grid, stream); }
        else if (l == 1) { launch_kind<K_BAND_IN>(a, l, grid, stream); launch_kind<K_BAND>(a, l, grid, stream); }
        else if (l == 2) { launch_kind<K_GDN_IN>(a, l, grid, stream); launch_kind<K_D1>(a, l, grid, stream); launch_kind<K_D2>(a, l, grid, stream); launch_kind<K_D3>(a, l, grid, stream); }
        else { launch_kind<K_SB_IN>(a, l, grid, stream); launch_kind<K_SB>(a, l, grid, stream); }
        launch_kind<K_OUT>(a, l, grid, stream); launch_kind<K_UP2>(a, l, grid, stream); launch_kind<K_DN2>(a, l, grid, stream);
    }
#endif
}
```

```cpp
#include <hip/hip_runtime.h>
#include <cstdio>
#include <cstdint>


namespace pg8 {
#define PG8_LAS __attribute__((address_space(3)))
typedef unsigned short bf16_t;
typedef short bf16x8 __attribute__((ext_vector_type(8)));
typedef float f32x4 __attribute__((ext_vector_type(4)));
typedef unsigned u32x4 __attribute__((ext_vector_type(4)));
constexpr int BM = 256, BK = 64, HALF = 128, HTB = HALF * BK * 2  , STAGE_BYTES = 8 * HTB, NXCD = 8, WGM = 8;

__host__ __device__ __forceinline__ int lds_byte(int r, int c) { const int st = (r >> 4) * 2 + (c >> 5), rr = r & 15, cc = c & 31, ob = rr * 64 + cc * 2; return st * 1024 + (ob ^ (((ob >> 9) & 1) << 5)); }
__host__ __device__ __forceinline__ void stage_rc(int b, int& R, int& C) { const int st = b / 1024, sb = b % 1024, swz = sb ^ (((sb >> 9) & 1) << 5); R = (st >> 1) * 16 + swz / 64; C = (st & 1) * 32 + (swz % 64) / 2; }
__host__ __device__ __forceinline__ int perm32(int rho) { const int n = rho >> 4, i = rho & 15; return 8 * (i >> 2) + 4 * n + (i & 3); }

struct Unit { int pm, pn; };
struct Gemm { const bf16_t* A; const bf16_t* Bt; int M, N, K; };

struct StaticOrder {
    int nM, nN, nwg, G, c;
    __host__ __device__ void init(int M, int N, int G_, int c_) { nM = M / BM; nN = N / BM; nwg = nM * nN; G = G_; c = c_; }
    __host__ __device__ bool next(int i, Unit& u) const {
        const long L = (long)i * G + c; if (L >= nwg) return false;
        int wgid = (int)L; { const int q = nwg / NXCD, r = nwg % NXCD, xcd = wgid % NXCD, off = wgid / NXCD; wgid = (xcd < r ? xcd * (q + 1) : r * (q + 1) + (xcd - r) * q) + off; }
        const int nig = WGM * nN, gid = wgid / nig, fm = gid * WGM, gsz = (nM - fm) < WGM ? (nM - fm) : WGM;
        u.pm = fm + ((wgid % nig) % gsz); u.pn = (wgid % nig) / gsz; return true;
    }
    __device__ __forceinline__ void a_ready(const Unit&) const {}
    __device__ __forceinline__ void done(const Unit&) const {}
};
__device__ __forceinline__ unsigned cvt_pk_bf16(float lo, float hi) { unsigned r; asm volatile("v_cvt_pk_bf16_f32 %0, %1, %2" : "=v"(r) : "v"(lo), "v"(hi)); return r; }

template <class Epi, class Sched, bool ALIGN_EPI = false, bool SP2 = false>
__device__ __forceinline__ void gemm_phase(PG8_LAS unsigned char* lds, const Gemm g, const Sched& S, const Epi& E) {
    int tid = threadIdx.x; asm volatile("" : "+v"(tid)); const int wid = __builtin_amdgcn_readfirstlane(tid >> 6), lane = tid & 63, wr = wid >> 2, wc = wid & 3, fr = lane & 15, fq = lane >> 4;
    const int K = g.K, nt = K / BK;
    unsigned voffA[2], voffB[2];
#pragma unroll
    for (int i = 0; i < 2; ++i) { int R, C; stage_rc(tid * 16 + i * 8192, R, C); const int Rb = Epi::PERM ? ((R & ~31) + perm32(R & 31)) : R;
        voffA[i] = (unsigned)(R * K + C) * 2u; voffB[i] = (unsigned)(Rb * K + C) * 2u; }
    const size_t kstep = (size_t)(BK * 2);
    const size_t hstep = (size_t)HALF * K * 2;
    const size_t tstep = 2 * hstep;
    const unsigned ldsw = (unsigned)wid * 1024u;
    const int aoff = lds_byte(wr * 64 + fr, fq * 8), boff = lds_byte(wc * 32 + fr, fq * 8);
#define PG8_SA(b, h) (((b) * 2 + (h)) * HTB)
#define PG8_SB(b, h) ((4 + (b) * 2 + (h)) * HTB)
#define PG8_STAGE(bufoff, gbase, voff) do { _Pragma("unroll") for (int _i = 0; _i < 2; ++_i) \
        __builtin_amdgcn_global_load_lds((const unsigned*)((const char*)(gbase) + (voff)[_i]), (PG8_LAS unsigned*)(lds + (bufoff) + ldsw + _i * 8192), 16, 0, 0); } while (0)
#define PG8_LDA(dst, b, h) do { _Pragma("unroll") for (int m = 0; m < 4; ++m) _Pragma("unroll") for (int k = 0; k < 2; ++k) dst[m][k] = *(const PG8_LAS bf16x8*)(lds + PG8_SA(b, h) + aoff + m * 2048 + k * 1024); } while (0)
#define PG8_LDB(dst, b, h) do { _Pragma("unroll") for (int n = 0; n < 2; ++n) _Pragma("unroll") for (int k = 0; k < 2; ++k) dst[n][k] = *(const PG8_LAS bf16x8*)(lds + PG8_SB(b, h) + boff + n * 2048 + k * 1024); } while (0)
#define PG8_MMA(ai, bj, At, Bt) do { __builtin_amdgcn_s_setprio(1); _Pragma("unroll") for (int m = 0; m < 4; ++m) _Pragma("unroll") for (int n = 0; n < 2; ++n) _Pragma("unroll") for (int k = 0; k < 2; ++k) \
        acc[ai][bj][m][n] = __builtin_amdgcn_mfma_f32_16x16x32_bf16(Bt[n][k], At[m][k], acc[ai][bj][m][n], 0, 0, 0); __builtin_amdgcn_s_setprio(0); } while (0)
#define PG8_WAIT_V(n) asm volatile("s_waitcnt vmcnt(" #n ")" ::: "memory")
#define PG8_WAIT_L(n) asm volatile("s_waitcnt lgkmcnt(" #n ")" ::: "memory")
#define PG8_BAR __builtin_amdgcn_s_barrier()
#define PG8_SCHED __builtin_amdgcn_sched_barrier(0)
    Unit cur, nxt; int ui = 0;
    if (!S.next(0, cur)) return;
    f32x4 acc[2][2][4][2];
#pragma unroll
    for (int a = 0; a < 2; ++a)
#pragma unroll
        for (int b = 0; b < 2; ++b)
#pragma unroll
            for (int m = 0; m < 4; ++m)
#pragma unroll
                for (int n = 0; n < 2; ++n) acc[a][b][m][n] = (f32x4){0.f, 0.f, 0.f, 0.f};
    bf16x8 At[4][2], B0[2][2], B1[2][2];
    const char* cA = (const char*)g.A + (size_t)cur.pm * tstep; const char* cB = (const char*)g.Bt + (size_t)cur.pn * tstep;
    S.a_ready(cur);
    if constexpr (SP2) {
        PG8_STAGE(PG8_SB(0, 0), cB, voffB); PG8_STAGE(PG8_SB(0, 1), cB + hstep, voffB); PG8_STAGE(PG8_SA(0, 0), cA, voffA); PG8_STAGE(PG8_SA(0, 1), cA + hstep, voffA);
        if (wr == 1) PG8_BAR;
        PG8_WAIT_V(2); PG8_BAR;
        PG8_STAGE(PG8_SB(1, 0), cB + kstep, voffB); PG8_STAGE(PG8_SA(1, 0), cA + kstep, voffA); PG8_STAGE(PG8_SB(1, 1), cB + hstep + kstep, voffB);
        PG8_WAIT_V(6); PG8_BAR;
    } else {
        PG8_STAGE(PG8_SB(0, 0), cB, voffB); PG8_STAGE(PG8_SA(0, 0), cA, voffA); PG8_STAGE(PG8_SB(0, 1), cB + hstep, voffB); PG8_STAGE(PG8_SA(0, 1), cA + hstep, voffA);
        if (wr == 1) PG8_BAR;
        PG8_WAIT_V(4); PG8_BAR;
        PG8_STAGE(PG8_SB(1, 0), cB + kstep, voffB); PG8_STAGE(PG8_SA(1, 0), cA + kstep, voffA); PG8_STAGE(PG8_SB(1, 1), cB + hstep + kstep, voffB);
        PG8_WAIT_V(6); PG8_BAR;
    }
    for (;;) {
        const bool has_next = S.next(ui + 1, nxt);
        const char* nA = has_next ? (const char*)g.A + (size_t)nxt.pm * tstep : cA; const char* nB = has_next ? (const char*)g.Bt + (size_t)nxt.pn * tstep : cB;
        for (int t = 0; t < nt; t += 2) {
            const bool last = (t == nt - 2);
            const char* a1 = cA + (size_t)(t + 1) * kstep;
            const char* a2 = last ? nA : cA + (size_t)(t + 2) * kstep; const char* b2 = last ? nB : cB + (size_t)(t + 2) * kstep;
            const char* a3 = a2 + kstep; const char* b3 = b2 + kstep;
            if (last && has_next) S.a_ready(nxt);
            if constexpr (SP2) {
            PG8_LDB(B0, 0, 0); PG8_LDB(B1, 0, 1); PG8_SCHED; PG8_LDA(At, 0, 0); PG8_STAGE(PG8_SA(1, 1), a1 + hstep, voffA);
            PG8_WAIT_V(8); PG8_WAIT_L(0); PG8_BAR; PG8_MMA(0, 0, At, B0); PG8_MMA(0, 1, At, B1); PG8_BAR; PG8_SCHED;
            PG8_LDA(At, 0, 1); PG8_STAGE(PG8_SB(0, 0), b2, voffB); PG8_STAGE(PG8_SB(0, 1), b2 + hstep, voffB); PG8_STAGE(PG8_SA(0, 0), a2, voffA);
            PG8_WAIT_V(8); PG8_WAIT_L(0); PG8_BAR; PG8_MMA(1, 0, At, B0); PG8_MMA(1, 1, At, B1); PG8_BAR; PG8_SCHED;
            PG8_LDB(B0, 1, 0); PG8_LDB(B1, 1, 1); PG8_SCHED; PG8_LDA(At, 1, 0); PG8_STAGE(PG8_SA(0, 1), a2 + hstep, voffA);
            PG8_WAIT_V(8); PG8_WAIT_L(0); PG8_BAR; PG8_MMA(0, 0, At, B0); PG8_MMA(0, 1, At, B1); PG8_BAR; PG8_SCHED;
            PG8_LDA(At, 1, 1); PG8_STAGE(PG8_SB(1, 0), b3, voffB); PG8_STAGE(PG8_SB(1, 1), b3 + hstep, voffB); PG8_STAGE(PG8_SA(1, 0), a3, voffA);
            PG8_WAIT_V(8); PG8_WAIT_L(0); PG8_BAR; PG8_MMA(1, 0, At, B0); PG8_MMA(1, 1, At, B1); PG8_BAR; PG8_SCHED;
            } else {
            PG8_LDB(B0, 0, 0); PG8_SCHED; PG8_LDA(At, 0, 0); PG8_STAGE(PG8_SA(1, 1), a1 + hstep, voffA);
            PG8_WAIT_L(8); PG8_BAR; PG8_WAIT_L(0); PG8_MMA(0, 0, At, B0); PG8_BAR; PG8_SCHED;
            PG8_LDB(B1, 0, 1); PG8_STAGE(PG8_SB(0, 0), b2, voffB);
            PG8_BAR; PG8_WAIT_L(0); PG8_MMA(0, 1, At, B1); PG8_BAR;
            PG8_LDA(At, 0, 1); PG8_STAGE(PG8_SA(0, 0), a2, voffA);
            PG8_BAR; PG8_WAIT_L(0); PG8_MMA(1, 0, At, B0); PG8_BAR; PG8_SCHED;
            PG8_STAGE(PG8_SB(0, 1), b2 + hstep, voffB);
            PG8_WAIT_V(6); PG8_BAR; PG8_MMA(1, 1, At, B1); PG8_BAR;
            PG8_LDB(B0, 1, 0); PG8_SCHED; PG8_LDA(At, 1, 0); PG8_STAGE(PG8_SA(0, 1), a2 + hstep, voffA);
            PG8_WAIT_L(8); PG8_BAR; PG8_WAIT_L(0); PG8_MMA(0, 0, At, B0); PG8_BAR; PG8_SCHED;
            PG8_LDB(B1, 1, 1); PG8_STAGE(PG8_SB(1, 0), b3, voffB);
            PG8_BAR; PG8_WAIT_L(0); PG8_MMA(0, 1, At, B1); PG8_BAR;
            PG8_LDA(At, 1, 1); PG8_STAGE(PG8_SA(1, 0), a3, voffA);
            PG8_BAR; PG8_WAIT_L(0); PG8_MMA(1, 0, At, B0); PG8_BAR; PG8_SCHED;
            PG8_STAGE(PG8_SB(1, 1), b3 + hstep, voffB);
            PG8_WAIT_V(6); PG8_BAR; PG8_MMA(1, 1, At, B1); PG8_BAR;
            }
        }
        if constexpr (ALIGN_EPI) { if (wr == 0) PG8_BAR; }
        if constexpr (!Epi::AFTER_DRAIN) { E(acc, cur, wr, wc, fr, fq); S.done(cur); }
        if (!has_next) break;
#pragma unroll
        for (int a = 0; a < 2; ++a)
#pragma unroll
            for (int b = 0; b < 2; ++b)
#pragma unroll
                for (int m = 0; m < 4; ++m)
#pragma unroll
                    for (int n = 0; n < 2; ++n) acc[a][b][m][n] = (f32x4){0.f, 0.f, 0.f, 0.f};
        cur = nxt; cA = nA; cB = nB; ++ui;
        if constexpr (ALIGN_EPI) { if (wr == 1) PG8_BAR; }
    }
    PG8_WAIT_V(0);
    if constexpr (!ALIGN_EPI) { if (wr == 0) PG8_BAR; }
    PG8_BAR;
    if constexpr (Epi::AFTER_DRAIN) { E.fused(acc, cur, wr, wc, fr, fq, lds, wid, lane); S.done(cur); }
#undef PG8_SA
#undef PG8_SB
#undef PG8_STAGE
#undef PG8_LDA
#undef PG8_LDB
#undef PG8_MMA
#undef PG8_WAIT_V
#undef PG8_WAIT_L
#undef PG8_BAR
#undef PG8_SCHED
}
}

#define LAS __attribute__((address_space(3)))
typedef unsigned short bf16_t;
typedef short bf16x8 __attribute__((ext_vector_type(8)));
typedef short s16x4 __attribute__((ext_vector_type(4)));
typedef float f32x4 __attribute__((ext_vector_type(4)));
typedef float f32x2 __attribute__((ext_vector_type(2)));
typedef unsigned u32x4 __attribute__((ext_vector_type(4)));
typedef unsigned u32x2 __attribute__((ext_vector_type(2)));
#define DI __device__ __forceinline__
#define MFMA16(a, b, c) __builtin_amdgcn_mfma_f32_16x16x32_bf16((a), (b), (c), 0, 0, 0)

constexpr int D = 1024, FF = 2816, MP = 16384, MS = 2048, M = MP + MS, SEQ = 8192;
constexpr float EPS = 1e-6f;
constexpr int NT = 512;
constexpr int NSSQ = 13;

constexpr size_t O_Y = 0;
constexpr size_t O_GLA_P = (size_t)M * D;
constexpr size_t O_GLA_S = O_GLA_P + 2 * 4 * 128 * 256;
constexpr size_t O_BK_P = O_GLA_S + 32 * 4 * 128 * 256;
constexpr size_t O_BV_P = O_BK_P + 2 * 512 * 1024;
constexpr size_t O_BK_S = O_BV_P + 2 * 512 * 1024;
constexpr size_t O_BV_S = O_BK_S + 32 * 64 * 1024;
constexpr size_t O_GDN_P = O_BV_S + 32 * 64 * 1024;
constexpr size_t O_GDNC_P = O_GDN_P + 2 * 8 * 128 * 128;
constexpr size_t O_GDN_S = O_GDNC_P + 2 * 3 * 3072;
constexpr size_t O_GDNC_S = O_GDN_S + 32 * 8 * 128 * 128;
constexpr size_t O_SBK_P = O_GDNC_S + 32 * 3 * 3072;
constexpr size_t O_SBV_P = O_SBK_P + (size_t)MP * 1024;
constexpr size_t O_SBK_S = O_SBV_P + (size_t)MP * 1024;
constexpr size_t O_SBV_S = O_SBK_S + (size_t)MS * 1024;
constexpr size_t O_END = O_SBV_S + (size_t)MS * 1024;

constexpr size_t MiB = 1u << 20;
constexpr size_t WS_CTL = 0, CTL_ZERO_BYTES = 128 * 1024;
constexpr int CW_BAR = 4096;
constexpr size_t WS_GNB = 128 * 1024;
constexpr size_t SZ_WUP = (size_t)2 * FF * D * 2, SZ_WDN = (size_t)D * FF * 2;
constexpr size_t WS_SSQ = 2 * MiB;
constexpr size_t WS_WFFN = 18 * MiB;
constexpr size_t SZ_WFFN_L = 2 * (SZ_WUP + SZ_WDN);
constexpr size_t WS_WGLA_IN = WS_WFFN + 4 * SZ_WFFN_L;
constexpr size_t WS_WGLA_OUT = WS_WGLA_IN + (size_t)3584 * D * 2;
constexpr size_t WS_WBAND_IN = WS_WGLA_OUT + (size_t)D * D * 2;
constexpr size_t WS_WBAND_OUT = WS_WBAND_IN + (size_t)3072 * D * 2;
constexpr size_t WS_WGDN_IN = WS_WBAND_OUT + (size_t)D * D * 2;
constexpr size_t WS_WGDN_OUT = WS_WGDN_IN + (size_t)4352 * D * 2;
constexpr size_t WS_WSB_IN = WS_WGDN_OUT + (size_t)D * D * 2;
constexpr size_t WS_WSB_OUT = WS_WSB_IN + (size_t)3072 * D * 2;
constexpr size_t WS_XB = (WS_WSB_OUT + (size_t)D * D * 2 + 4095) & ~(size_t)4095;
constexpr size_t WS_ACT = WS_XB + (size_t)M * D * 2;
constexpr size_t WS_OB = WS_ACT + (size_t)M * FF * 2;
constexpr size_t WS_MIX = WS_OB + (size_t)M * D * 2;
constexpr size_t GLA_Q = WS_MIX;
constexpr size_t GLA_K = GLA_Q + (size_t)M * 512 * 2;
constexpr size_t GLA_V = GLA_K + (size_t)M * 512 * 2;
constexpr size_t GLA_R = GLA_V + (size_t)M * 1024 * 2;
constexpr size_t GLA_LA = GLA_R + (size_t)M * 1024 * 2;
constexpr size_t GLA_UT = GLA_LA + (size_t)M * 512 * 4;
constexpr size_t GLA_DL = GLA_UT + (size_t)1152 * 32768 * 4;
constexpr size_t GLA_ST = GLA_DL + (size_t)1152 * 128 * 4;
constexpr size_t GLA_END = GLA_ST + (size_t)1152 * 32768 * 2;
constexpr size_t AT_Q = WS_MIX, AT_K = AT_Q + (size_t)M * 1024 * 2, AT_V = AT_K + (size_t)M * 1024 * 2, AT_END = AT_V + (size_t)M * 1024 * 2;
constexpr size_t GDN_QKV = WS_MIX;
constexpr size_t GDN_GG = GDN_QKV + (size_t)M * 3072 * 2;
constexpr size_t GDN_BG = GDN_GG + (size_t)M * 1024 * 2;
constexpr size_t GDN_QE = GDN_BG + (size_t)M * 16 * 4;
constexpr size_t GDN_WN = GDN_QE + (size_t)2304 * 8192 * 2;
constexpr size_t GDN_KLT = GDN_WN + (size_t)2304 * 8192 * 2;
constexpr size_t GDN_ATT = GDN_KLT + (size_t)2304 * 8192 * 2;
constexpr size_t GDN_UT = GDN_ATT + (size_t)2304 * 4096 * 2;
constexpr size_t GDN_STB = GDN_UT + (size_t)2304 * 8192 * 4;
constexpr size_t GDN_VNT = GDN_STB + (size_t)2304 * 16384 * 2;
constexpr size_t GDN_DLAST = GDN_VNT + (size_t)2304 * 8192 * 2;
constexpr size_t GDN_END = GDN_DLAST + (size_t)2304 * 4;
constexpr size_t WS_END = (GDN_END > GLA_END ? GDN_END : GLA_END);
static_assert(AT_END <= WS_END, "ws map");

constexpr int LDS_BYTES = 147456;
constexpr int RING_BYTES = 131072;
constexpr int MISC_OFF = RING_BYTES + 320;

DI int otid() { int t = threadIdx.x; asm volatile("" : "+v"(t)); return t; }
DI void lds_barrier() { asm volatile("s_waitcnt lgkmcnt(0)" ::: "memory"); __builtin_amdgcn_s_barrier(); asm volatile("" ::: "memory"); }
DI unsigned pk_bf16(float lo, float hi) { typedef __bf16 bf2 __attribute__((ext_vector_type(2))); f32x2 v = {lo, hi}; bf2 b = __builtin_convertvector(v, bf2); return __builtin_bit_cast(unsigned, b); }
DI float bf_lo(unsigned u) { return __uint_as_float(u << 16); }
DI float bf_hi(unsigned u) { return __uint_as_float(u & 0xffff0000u); }
DI float bf2f(bf16_t b) { return __uint_as_float(((unsigned)b) << 16); }
DI float fast_exp(float x) { return __builtin_amdgcn_exp2f(x * 1.4426950408889634f); }
DI float fast_log(float x) { return __builtin_amdgcn_logf(x) * 0.6931471805599453f; }
DI float fast_rcp(float x) { return __builtin_amdgcn_rcpf(x); }
DI float sigmoidf_(float x) { return fast_rcp(1.0f + fast_exp(-x)); }
DI float siluf_(float x) { return x * sigmoidf_(x); }
DI float softplusf_(float x) { return fmaxf(x, 0.f) + fast_log(1.0f + fast_exp(-fabsf(x))); }
DI float rsq(float x) { return __builtin_amdgcn_rsqf(x); }
DI float row_rs(const float* ssq, int row) { const f32x4* p = (const f32x4*)(ssq + (size_t)row * 16); const f32x4 a = p[0], b = p[1], c = p[2], d = p[3];
    const f32x4 s = (a + b) + (c + d); return rsq(((s[0] + s[1]) + (s[2] + s[3])) * (1.0f / 1024.0f) + EPS); }
DI float wave_sum(float v) {
#pragma unroll
    for (int o = 1; o < 64; o <<= 1) v += __shfl_xor(v, o);
    return v;
}
DI bf16x8 ldfrag_l(const LAS unsigned char* p) { return *(const LAS bf16x8*)p; }
DI bf16x8 ldfrag_g(const bf16_t* p) { return *(const bf16x8*)p; }
DI bf16x8 ldfrag2_g(const bf16_t* p0, const bf16_t* p1) { const s16x4 a = *(const s16x4*)p0, b = *(const s16x4*)p1; return __builtin_shufflevector(a, b, 0, 1, 2, 3, 4, 5, 6, 7); }
DI s16x4 tr4(const LAS unsigned char* p) { typedef short v4i16 __attribute__((ext_vector_type(4))); return __builtin_bit_cast(s16x4, __builtin_amdgcn_ds_read_tr16_b64_v4i16((LAS v4i16*)p)); }
DI bf16x8 trfrag(const LAS unsigned char* p0, const LAS unsigned char* p1) { const s16x4 a = tr4(p0), b = tr4(p1); return __builtin_shufflevector(a, b, 0, 1, 2, 3, 4, 5, 6, 7); }
DI bf16x8 packfrag(const f32x4& a, const f32x4& b) { u32x4 w; w.x = pk_bf16(a[0], a[1]); w.y = pk_bf16(a[2], a[3]); w.z = pk_bf16(b[0], b[1]); w.w = pk_bf16(b[2], b[3]); return __builtin_bit_cast(bf16x8, w); }
DI void unpack8(const u32x4 w, float (&f)[8]) { f[0] = bf_lo(w.x); f[1] = bf_hi(w.x); f[2] = bf_lo(w.y); f[3] = bf_hi(w.y); f[4] = bf_lo(w.z); f[5] = bf_hi(w.z); f[6] = bf_lo(w.w); f[7] = bf_hi(w.w); }
DI u32x4 pack8(const float (&f)[8]) { u32x4 w; w.x = pk_bf16(f[0], f[1]); w.y = pk_bf16(f[2], f[3]); w.z = pk_bf16(f[4], f[5]); w.w = pk_bf16(f[6], f[7]); return w; }

struct KArgs { const float* in[34]; float* out; unsigned char* ws; };
constexpr int ARGS_OFF = RING_BYTES + 1024;
struct InTab { const LAS unsigned* t;
    DI const void* ptr(int i) const { const unsigned lo = __builtin_amdgcn_readfirstlane(t[2 * i]), hi = __builtin_amdgcn_readfirstlane(t[2 * i + 1]); typedef __attribute__((address_space(1))) const char gchar; gchar* g = (gchar*)(((unsigned long long)hi << 32) | lo); return (const void*)g; }
    DI const float* operator[](int i) const { return (const float*)ptr(i); } };
struct Args { InTab in; float* out; unsigned char* ws; };
DI void store_args(const KArgs& k, LAS unsigned char* lds) {
    if (threadIdx.x < 36) { const unsigned long long v = threadIdx.x < 34 ? (unsigned long long)k.in[threadIdx.x] : (threadIdx.x == 34 ? (unsigned long long)k.out : (unsigned long long)k.ws);
        *(LAS unsigned long long*)(lds + ARGS_OFF + 8 * threadIdx.x) = v; }
}
DI Args load_args(LAS unsigned char* lds) { Args a; a.in.t = (const LAS unsigned*)(lds + ARGS_OFF); a.out = (float*)a.in.ptr(34); a.ws = (unsigned char*)a.in.ptr(35); return a; }


#define XB_TMO      128
#define XB_XCNT(j)  (256  + 64 * (j))
#define XB_XSUB(j)  (1280 + 64 * (j))
#define XB_XGEN(j)  (2304 + 64 * (j))
#define XB_TOP      3328
#define XB_TOPGEN   3392
#define XCD_BAR_WORDS 3456
#define XB_SPIN_CAP (1u << 18)

__device__ __forceinline__ unsigned xb_ld(unsigned* p)              { return __hip_atomic_load(p, __ATOMIC_RELAXED, __HIP_MEMORY_SCOPE_AGENT); }
__device__ __forceinline__ unsigned xb_add(unsigned* p, unsigned v) { return __hip_atomic_fetch_add(p, v, __ATOMIC_RELAXED, __HIP_MEMORY_SCOPE_AGENT); }
__device__ __forceinline__ unsigned xb_xcc_id() { return (unsigned)__builtin_amdgcn_s_getreg((3 << 11) | 20) & 0xFu; }
#define XB_SPIN(cond, bar) do { unsigned _sp = 0; while (cond) { __builtin_amdgcn_s_sleep(1); \
    if ((++_sp & 255u) == 0u) { if (xb_ld(&(bar)[XB_TMO])) break; if (_sp > XB_SPIN_CAP) { atomicAdd(&(bar)[XB_TMO], 1u); break; } } } } while (0)

struct XcdBarrier {
    unsigned* bar; unsigned x;
    volatile LAS unsigned* st;
};

__device__ __forceinline__ XcdBarrier xcd_barrier_post(unsigned* bar, volatile LAS unsigned* st) {
    XcdBarrier b; b.bar = bar; b.x = xb_xcc_id(); b.st = st;
    if (threadIdx.x == 0) (void)xb_add(&bar[XB_XCNT(b.x)], 1u);
    return b;
}
__device__ __forceinline__ void xcd_barrier_complete(unsigned* bar, unsigned x, unsigned& nloc, unsigned& nx) {
    const unsigned G = gridDim.x * gridDim.y * gridDim.z;
    unsigned sum, cnt, mine, sp = 0u;
    for (;;) {
        sum = 0u; cnt = 0u; mine = 0u;
#pragma unroll
        for (unsigned j = 0; j < 16; ++j) { const unsigned c = xb_ld(&bar[XB_XCNT(j)]); sum += c; cnt += (c > 0u) ? 1u : 0u; mine = (j == x) ? c : mine; }
        if (sum == G) break;
        __builtin_amdgcn_s_sleep(1);
        if ((++sp & 255u) == 0u) { if (xb_ld(&bar[XB_TMO])) break; if (sp > XB_SPIN_CAP) { atomicAdd(&bar[XB_TMO], 1u); break; } }
    }
    nloc = mine > 0u ? mine : 1u; nx = cnt > 0u ? cnt : 1u;
}

__device__ __forceinline__ void xcd_barrier(const XcdBarrier& b) {
    asm volatile("s_waitcnt vmcnt(0)" ::: "memory");
    __syncthreads();
    if (threadIdx.x == 0) {
        unsigned* bar = b.bar;
        __builtin_amdgcn_s_waitcnt(0);
        unsigned nloc = b.st[0], nx = b.st[1];
        if (nloc == 0u) { xcd_barrier_complete(bar, b.x, nloc, nx); b.st[0] = nloc; b.st[1] = nx; }
        const unsigned old = xb_add(&bar[XB_XSUB(b.x)], 1u);
        const unsigned gen = old / nloc;
        if (old + 1u == (gen + 1u) * nloc) {
            __builtin_amdgcn_fence(__ATOMIC_RELEASE, "agent");
            asm volatile("s_waitcnt vmcnt(0)" ::: "memory");
            const unsigned og = xb_add(&bar[XB_TOP], 1u);
            const unsigned tg = og / nx;
            if (og + 1u == (tg + 1u) * nx) xb_add(&bar[XB_TOPGEN], 1u);
            else XB_SPIN(xb_ld(&bar[XB_TOPGEN]) == tg, bar);
            __builtin_amdgcn_fence(__ATOMIC_ACQUIRE, "agent");
            xb_add(&bar[XB_XGEN(b.x)], 1u);
            asm volatile("s_waitcnt vmcnt(0)" ::: "memory");
        } else {
            XB_SPIN(xb_ld(&bar[XB_XGEN(b.x)]) == gen, bar);
            __builtin_amdgcn_fence(__ATOMIC_ACQUIRE, "agent");
            asm volatile("s_waitcnt vmcnt(0)" ::: "memory");
        }
    }
    __syncthreads();
}

typedef f32x4 acc_t[2][2][4][2];

struct EpiSwiglu {
    static constexpr bool PERM = true, AFTER_DRAIN = false;
    bf16_t* ACT; const float* ssq;
    DI void operator()(const acc_t& acc, const pg8::Unit& u, int wr, int wc, int fr, int fq) const {
        const int row0 = u.pm * 256 + wr * 64 + fr, col0 = u.pn * 128 + wc * 32 + 8 * fq;
#pragma unroll
        for (int ai = 0; ai < 2; ++ai)
#pragma unroll
            for (int m = 0; m < 4; ++m) {
                const int row = row0 + ai * 128 + m * 16;
                const float rs = row_rs(ssq, row);
                float o[8];
#pragma unroll
                for (int n = 0; n < 2; ++n)
#pragma unroll
                    for (int i = 0; i < 4; ++i) { const float g = acc[ai][0][m][n][i] * rs, uu = acc[ai][1][m][n][i] * rs; o[n * 4 + i] = g * uu * fast_rcp(1.0f + fast_exp(-g)); }
                *(u32x4*)(ACT + (size_t)row * FF + col0) = pack8(o);
            }
    }
};
struct EpiResid {
    static constexpr bool PERM = false, AFTER_DRAIN = false;
    float* X; bf16_t* XB; float* ssq_next; float scale;
    DI void operator()(const acc_t& acc, const pg8::Unit& u, int wr, int wc, int fr, int fq) const {
        const int row0 = u.pm * 256 + wr * 64 + fr, col0 = u.pn * 256 + wc * 32 + 4 * fq;
#pragma unroll
        for (int ai = 0; ai < 2; ++ai)
#pragma unroll
            for (int m = 0; m < 4; ++m) {
                const int row = row0 + ai * 128 + m * 16; float ss = 0.f;
#pragma unroll
                for (int bj = 0; bj < 2; ++bj)
#pragma unroll
                    for (int n = 0; n < 2; ++n) {
                        const size_t off = (size_t)row * D + col0 + bj * 128 + n * 16;
                        const f32x4 xo = *(const f32x4*)(X + off); const f32x4 xn = xo + acc[ai][bj][m][n] * scale;
                        *(f32x4*)(X + off) = xn;
                        u32x2 w; w.x = pk_bf16(xn[0], xn[1]); w.y = pk_bf16(xn[2], xn[3]); *(u32x2*)(XB + off) = w;
                        ss += (xn[0] * xn[0] + xn[1] * xn[1]) + (xn[2] * xn[2] + xn[3] * xn[3]);
                    }
                ss += __shfl_xor(ss, 16); ss += __shfl_xor(ss, 32);
                if (fq == 0) ssq_next[(size_t)row * 16 + u.pn * 4 + wc] = ss;
            }
    }
};
struct EpiGlaIn {
    static constexpr bool PERM = true, AFTER_DRAIN = false;
    const float* ssq; bf16_t *Q, *K, *V, *R; float* LA; const float* b_gate;
    DI void operator()(const acc_t& acc, const pg8::Unit& u, int wr, int wc, int fr, int fq) const {
        const int row0 = u.pm * 256 + wr * 64 + fr, pn = u.pn, cw = wc * 32 + 8 * fq;
#pragma unroll
        for (int ai = 0; ai < 2; ++ai)
#pragma unroll
            for (int m = 0; m < 4; ++m) {
                const int row = row0 + ai * 128 + m * 16;
                const float rs = row_rs(ssq, row);
#pragma unroll
                for (int bj = 0; bj < 2; ++bj) {
                    float o[8];
#pragma unroll
                    for (int n = 0; n < 2; ++n)
#pragma unroll
                        for (int i = 0; i < 4; ++i) o[n * 4 + i] = acc[ai][bj][m][n][i] * rs;
                    const int ct = bj * 128 + cw;
                    if (pn < 2) {
#pragma unroll
                        for (int i = 0; i < 8; ++i) o[i] *= 0.08838834764831845f;
                        *(u32x4*)(Q + (size_t)row * 512 + pn * 256 + ct) = pack8(o);
                    } else if (pn < 4) { *(u32x4*)(K + (size_t)row * 512 + (pn - 2) * 256 + ct) = pack8(o);
                    } else if (pn < 8) { *(u32x4*)(V + (size_t)row * 1024 + (pn - 4) * 256 + ct) = pack8(o);
                    } else if (pn < 12) {
#pragma unroll
                        for (int i = 0; i < 8; ++i) o[i] = siluf_(o[i]);
                        *(u32x4*)(R + (size_t)row * 1024 + (pn - 8) * 256 + ct) = pack8(o);
                    } else {
                        const int c = (pn - 12) * 256 + ct;
                        const f32x4 b0 = *(const f32x4*)(b_gate + c), b1 = *(const f32x4*)(b_gate + c + 4);
                        f32x4 r0, r1;
#pragma unroll
                        for (int i = 0; i < 4; ++i) { r0[i] = -softplusf_(-(o[i] + b0[i])) * (1.0f / 16.0f); r1[i] = -softplusf_(-(o[4 + i] + b1[i])) * (1.0f / 16.0f); }
                        *(f32x4*)(LA + (size_t)row * 512 + c) = r0; *(f32x4*)(LA + (size_t)row * 512 + c + 4) = r1;
                    }
                }
            }
    }
};
struct EpiBandIn {
    static constexpr bool PERM = true, AFTER_DRAIN = false;
    const float* ssq; bf16_t* QKVb; const float* gnb; float* out;
    DI void operator()(const acc_t& acc, const pg8::Unit& u, int wr, int wc, int fr, int fq) const {
        const int row0 = u.pm * 256 + wr * 64 + fr, pn = u.pn, which = pn >> 2, head = 4 * (pn & 3) + wc;
        bf16_t* dst = QKVb + (size_t)which * M * 1024;
#pragma unroll
        for (int ai = 0; ai < 2; ++ai)
#pragma unroll
            for (int m = 0; m < 4; ++m) {
                const int row = row0 + ai * 128 + m * 16;
                const float rs = row_rs(ssq, row);
                float o[2][8]; float ss = 0.f;
#pragma unroll
                for (int bj = 0; bj < 2; ++bj)
#pragma unroll
                    for (int n = 0; n < 2; ++n)
#pragma unroll
                        for (int i = 0; i < 4; ++i) { const float v = acc[ai][bj][m][n][i] * rs; o[bj][n * 4 + i] = v; ss += v * v; }
                if (which < 2) {
                    ss += __shfl_xor(ss, 16); ss += __shfl_xor(ss, 32);
                    float hs = rsq(ss * (1.0f / 64.0f) + EPS); if (which == 0) hs *= 0.125f;
                    const float* gn = gnb + which * 64;
#pragma unroll
                    for (int bj = 0; bj < 2; ++bj) {
                        const f32x4 g0 = *(const f32x4*)(gn + bj * 32 + 8 * fq), g1 = *(const f32x4*)(gn + bj * 32 + 8 * fq + 4);
#pragma unroll
                        for (int i = 0; i < 4; ++i) { o[bj][i] *= hs * g0[i]; o[bj][4 + i] *= hs * g1[i]; }
                    }
                }
                bool has_fo = false; size_t fo_off = 0;
                if (which > 0) {
                    if (row >= MP) { has_fo = true; fo_off = O_BK_S + (size_t)(which - 1) * MS * 1024 + (size_t)(row - MP) * 1024; }
                    else { const int t = row & (SEQ - 1), b = row >> 13; if (t >= SEQ - 512) { has_fo = true; fo_off = O_BK_P + (size_t)(which - 1) * 2 * 512 * 1024 + (size_t)(b * 512 + t - (SEQ - 512)) * 1024; } }
                }
                float* fo = out + fo_off;
#pragma unroll
                for (int bj = 0; bj < 2; ++bj) {
                    const int c = head * 64 + bj * 32 + 8 * fq;
                    *(u32x4*)(dst + (size_t)row * 1024 + c) = pack8(o[bj]);
                    if (has_fo) { *(f32x4*)(fo + c) = (f32x4){o[bj][0], o[bj][1], o[bj][2], o[bj][3]}; *(f32x4*)(fo + c + 4) = (f32x4){o[bj][4], o[bj][5], o[bj][6], o[bj][7]}; }
                }
            }
    }
};
struct EpiGdnIn {
    static constexpr bool PERM = true, AFTER_DRAIN = false;
    const float* ssq; bf16_t *QKV, *GG; float* BG; const float *a_log, *dt_bias; float *ocp, *ocs;
    DI void operator()(const acc_t& acc, const pg8::Unit& u, int wr, int wc, int fr, int fq) const {
        const int row0 = u.pm * 256 + wr * 64 + fr, pn = u.pn, cw = wc * 32 + 8 * fq;
#pragma unroll
        for (int ai = 0; ai < 2; ++ai)
#pragma unroll
            for (int m = 0; m < 4; ++m) {
                const int row = row0 + ai * 128 + m * 16;
                const float rs = row_rs(ssq, row);
                float* fo = nullptr;
                if (row >= MP) { const int t = (row - MP) & 63, b = (row - MP) >> 6; if (t >= 61) fo = ocs + (size_t)(b * 3 + t - 61) * 3072; }
                else { const int t = row & (SEQ - 1), b = row >> 13; if (t >= SEQ - 3) fo = ocp + (size_t)(b * 3 + t - (SEQ - 3)) * 3072; }
#pragma unroll
                for (int bj = 0; bj < 2; ++bj) {
                    float o[8];
#pragma unroll
                    for (int n = 0; n < 2; ++n)
#pragma unroll
                        for (int i = 0; i < 4; ++i) o[n * 4 + i] = acc[ai][bj][m][n][i] * rs;
                    const int ct = bj * 128 + cw;
                    if (pn < 12) {
                        const int c = pn * 256 + ct;
                        *(u32x4*)(QKV + (size_t)row * 3072 + c) = pack8(o);
                        if (fo) { *(f32x4*)(fo + c) = (f32x4){o[0], o[1], o[2], o[3]}; *(f32x4*)(fo + c + 4) = (f32x4){o[4], o[5], o[6], o[7]}; }
                    } else if (pn < 16) {
#pragma unroll
                        for (int i = 0; i < 8; ++i) o[i] = siluf_(o[i]);
                        *(u32x4*)(GG + (size_t)row * 1024 + (pn - 12) * 256 + ct) = pack8(o);
                    } else if (ct < 16) {
                        float r[8];
                        if (ct == 0) {
#pragma unroll
                            for (int i = 0; i < 8; ++i) r[i] = sigmoidf_(o[i]);
                        } else {
#pragma unroll
                            for (int i = 0; i < 8; ++i) r[i] = -fast_exp(a_log[i]) * softplusf_(o[i] + dt_bias[i]);
                        }
                        *(f32x4*)(BG + (size_t)row * 16 + ct) = (f32x4){r[0], r[1], r[2], r[3]}; *(f32x4*)(BG + (size_t)row * 16 + ct + 4) = (f32x4){r[4], r[5], r[6], r[7]};
                    }
                }
            }
    }
};
struct EpiSbIn {
    static constexpr bool PERM = true, AFTER_DRAIN = false;
    const float* ssq; bf16_t* QKVb; float* okv;
    DI void operator()(const acc_t& acc, const pg8::Unit& u, int wr, int wc, int fr, int fq) const {
        const int row0 = u.pm * 256 + wr * 64 + fr, pn = u.pn, which = pn >> 2, cw = (pn & 3) * 256 + wc * 32 + 8 * fq;
        bf16_t* dst = QKVb + (size_t)which * M * 1024;
#pragma unroll
        for (int ai = 0; ai < 2; ++ai)
#pragma unroll
            for (int m = 0; m < 4; ++m) {
                const int row = row0 + ai * 128 + m * 16;
                float rs = row_rs(ssq, row); if (which == 0) rs *= 0.125f;
                const size_t fo_off = (row >= MP) ? (size_t)2 * MP * 1024 + (size_t)(which - 1) * MS * 1024 + (size_t)(row - MP) * 1024 : (size_t)(which - 1) * MP * 1024 + (size_t)row * 1024;
                float* fo = okv + fo_off;
#pragma unroll
                for (int bj = 0; bj < 2; ++bj) {
                    float o[8];
#pragma unroll
                    for (int n = 0; n < 2; ++n)
#pragma unroll
                        for (int i = 0; i < 4; ++i) o[n * 4 + i] = acc[ai][bj][m][n][i] * rs;
                    const int c = cw + bj * 128;
                    *(u32x4*)(dst + (size_t)row * 1024 + c) = pack8(o);
                    if (which > 0) { *(f32x4*)(fo + c) = (f32x4){o[0], o[1], o[2], o[3]}; *(f32x4*)(fo + c + 4) = (f32x4){o[4], o[5], o[6], o[7]}; }
                }
            }
    }
};


struct Job { const float* src; const float* gain; const float* aux; bf16_t* dst; int K, srcN, dstN, map; };
DI void get_job(const Args& a, int j, Job& o) {
    unsigned char* ws = a.ws; o.aux = nullptr; o.gain = nullptr; o.map = 0;
    if (j < 16) {
        const int l = j >> 2, kind = j & 3;
        bf16_t* base = (bf16_t*)(ws + WS_WFFN + (size_t)l * SZ_WFFN_L);
        if (kind == 0)      { o.src = a.in[10] + (size_t)l * D * 2 * FF; o.gain = a.in[9] + l * D;  o.dst = base; o.K = D; o.srcN = 2 * FF; o.dstN = 2 * FF; o.map = 1; }
        else if (kind == 1) { o.src = a.in[11] + (size_t)l * FF * D; o.dst = base + (size_t)2 * FF * D; o.K = FF; o.srcN = D; o.dstN = D; }
        else if (kind == 2) { o.src = a.in[14] + (size_t)l * D * 2 * FF; o.gain = a.in[13] + l * D; o.dst = base + (size_t)3 * FF * D; o.K = D; o.srcN = 2 * FF; o.dstN = 2 * FF; o.map = 1; }
        else                { o.src = a.in[15] + (size_t)l * FF * D; o.dst = base + (size_t)5 * FF * D; o.K = FF; o.srcN = D; o.dstN = D; }
        return;
    }
    o.K = D; o.srcN = D; o.dstN = D;
    switch (j) {
        case 16: o.src = a.in[16]; o.gain = a.in[12];         o.aux = a.in[17]; o.dst = (bf16_t*)(ws + WS_WGLA_IN); o.srcN = 3088; o.dstN = 3584; o.map = 3; break;
        case 17: o.src = a.in[20]; o.dst = (bf16_t*)(ws + WS_WGLA_OUT); break;
        case 18: o.src = a.in[21]; o.gain = a.in[12] + D;     o.dst = (bf16_t*)(ws + WS_WBAND_IN); o.srcN = 3072; o.dstN = 3072; o.map = 2; break;
        case 19: o.src = a.in[25]; o.dst = (bf16_t*)(ws + WS_WBAND_OUT); break;
        case 20: o.src = a.in[26]; o.gain = a.in[12] + 2 * D; o.dst = (bf16_t*)(ws + WS_WGDN_IN); o.srcN = 4112; o.dstN = 4352; o.map = 4; break;
        case 21: o.src = a.in[31]; o.dst = (bf16_t*)(ws + WS_WGDN_OUT); break;
        case 22: o.src = a.in[32]; o.gain = a.in[12] + 3 * D; o.dst = (bf16_t*)(ws + WS_WSB_IN); o.srcN = 3072; o.dstN = 3072; break;
        default: o.src = a.in[33]; o.dst = (bf16_t*)(ws + WS_WSB_OUT); break;
    }
}
DI int src_col(int map, int n0) {
    if (map == 1) { const int pn = n0 >> 8, s = n0 & 255; return s < 128 ? 128 * pn + s : FF + 128 * pn + (s - 128); }
    if (map == 2) { const int pn = n0 >> 8, s = n0 & 255, bj = s >> 7, wc = (s & 127) >> 5; return (pn >> 2) * 1024 + (4 * (pn & 3) + wc) * 64 + 32 * bj; }
    if (map == 3) return n0 < 3072 ? n0 : -2;
    if (map == 4) return n0 < 4096 ? n0 : (n0 == 4096 ? -3 : -1);
    return n0;
}
DI void transpose_item(const Job& J, LAS float* scr, int item, int lane) {
    const int nblk = J.dstN >> 5, kb = item / nblk, nb = item - kb * nblk, k0 = 64 * kb, n0 = 32 * nb;
    const int sc = src_col(J.map, n0);
    const int nl = lane & 31;
#pragma unroll 4
    for (int i = 0; i < 32; ++i) {
        const int kk = 2 * i + (lane >> 5), k = k0 + kk; float v = 0.f;
        if (sc >= 0) v = J.src[(size_t)k * J.srcN + sc + nl];
        else if (sc == -3) { if (nl < 16) v = J.src[(size_t)k * J.srcN + 4096 + nl]; }
        else if (sc == -2) {
            const float* wr_ = J.src + (size_t)k * J.srcN + 3072; const float* g2 = J.aux + (n0 - 3072) + nl;
#pragma unroll
            for (int r = 0; r < 16; ++r) v += wr_[r] * g2[r * 512];
        }
        if (J.gain) v *= J.gain[k];
        scr[kk * 33 + nl] = v;
    }
    asm volatile("s_waitcnt lgkmcnt(0)" ::: "memory");
    const int c = lane & 7;
#pragma unroll
    for (int j = 0; j < 4; ++j) { const int n = (lane >> 3) + 8 * j; const LAS float* s = scr + (8 * c) * 33 + n;
        u32x4 o; o.x = pk_bf16(s[0 * 33], s[1 * 33]); o.y = pk_bf16(s[2 * 33], s[3 * 33]); o.z = pk_bf16(s[4 * 33], s[5 * 33]); o.w = pk_bf16(s[6 * 33], s[7 * 33]);
        *(u32x4*)(J.dst + (size_t)(n0 + n) * J.K + k0 + 8 * c) = o; }
    asm volatile("s_waitcnt lgkmcnt(0)" ::: "memory");
}
DI void phase_prologue(const Args& a, LAS unsigned char* lds, int G, int bx) {
    const int tid = otid(), lane = tid & 63, wave = tid >> 6;
    LAS float* scr = (LAS float*)(lds + wave * 16384);
    const int gw = bx * 8 + wave, NGW = G * 8;
    for (int j = 0; j < 24; ++j) {
        Job J; get_job(a, j, J);
        const int nitems = (J.K >> 6) * (J.dstN >> 5);
        for (int it = gw; it < nitems; it += NGW) transpose_item(J, scr, it, lane);
    }
    if (bx == 0 && tid < 128) ((float*)(a.ws + WS_GNB))[tid] = tid < 64 ? a.in[22][tid] : a.in[23][tid - 64];
    float* X = a.out; bf16_t* XB = (bf16_t*)(a.ws + WS_XB); float* ssq0 = (float*)(a.ws + WS_SSQ);
    for (int m = gw; m < M; m += NGW) {
        const float* src = m < MP ? a.in[0] + (size_t)m * D : a.in[1] + (size_t)(m - MP) * D;
        float s = 0.f;
#pragma unroll
        for (int j = 0; j < 4; ++j) {
            const f32x4 v = *(const f32x4*)(src + 256 * j + 4 * lane);
            *(f32x4*)(X + (size_t)m * D + 256 * j + 4 * lane) = v;
            u32x2 w; w.x = pk_bf16(v[0], v[1]); w.y = pk_bf16(v[2], v[3]); *(u32x2*)(XB + (size_t)m * D + 256 * j + 4 * lane) = w;
            s += (v[0] * v[0] + v[1] * v[1]) + (v[2] * v[2] + v[3] * v[3]);
        }
        s = wave_sum(s);
        if (lane < 16) ssq0[(size_t)m * 16 + lane] = lane == 0 ? s : 0.f;
    }
}


constexpr int GLA_UNITS = 288 * 4;
constexpr int S128 = 288;
constexpr int S256 = 544;
constexpr int S64 = 160;

DI void gla_load_cumsum(LAS float* LA, const float* la_g, int row0, int h, int tid) {
#pragma unroll
    for (int i = 0; i < 4; ++i) { const int q = tid + i * NT, t = q >> 5, c4 = (q & 31) * 4;
        *(LAS f32x4*)(LA + t * 128 + c4) = *(const f32x4*)(la_g + (size_t)(row0 + t) * 512 + h * 128 + c4); }
    __syncthreads();
    if (tid < 128) { float run = 0.f;
#pragma unroll 8
        for (int t = 0; t < 64; ++t) { run += LA[t * 128 + tid]; LA[t * 128 + tid] = run; } }
    __syncthreads();
}
DI void gla_load_v(LAS unsigned char* VV, const bf16_t* Vg, int row0, int h, int tid) {
#pragma unroll
    for (int i = 0; i < 4; ++i) { const int q = tid + i * NT, t = q >> 5, c8 = (q & 31) * 8;
        *(LAS u32x4*)(VV + t * S256 + c8 * 2) = *(const u32x4*)(Vg + (size_t)(row0 + t) * 1024 + h * 256 + c8); }
}
DI void phase_gla_g1(const Args& a, LAS unsigned char* lds, int G, int bx) {
    const int tid = otid(), lane = tid & 63, wave = tid >> 6, i16 = lane & 15, quad = lane >> 4;
    LAS float* LA = (LAS float*)lds; LAS unsigned char* KL = lds + 32768; LAS unsigned char* VV = lds + 32768 + 64 * S128;
    const bf16_t* Kg = (const bf16_t*)(a.ws + GLA_K); const bf16_t* Vg = (const bf16_t*)(a.ws + GLA_V); const float* la_g = (const float*)(a.ws + GLA_LA);
    float* UT = (float*)(a.ws + GLA_UT); float* DL = (float*)(a.ws + GLA_DL);
    for (int uid = bx; uid < GLA_UNITS; uid += G) {
        const int cr = uid >> 2, h = uid & 3, row0 = cr * 64;
        gla_load_v(VV, Vg, row0, h, tid);
        gla_load_cumsum(LA, la_g, row0, h, tid);
#pragma unroll
        for (int i = 0; i < 2; ++i) { const int q = tid + i * NT, t = q >> 4, c8 = (q & 15) * 8;
            float kf[8]; unpack8(*(const u32x4*)(Kg + (size_t)(row0 + t) * 512 + h * 128 + c8), kf);
#pragma unroll
            for (int e = 0; e < 8; ++e) kf[e] *= fast_exp(LA[63 * 128 + c8 + e] - LA[t * 128 + c8 + e]);
            *(LAS u32x4*)(KL + t * S128 + c8 * 2) = pack8(kf); }
        if (tid < 128) DL[(size_t)uid * 128 + tid] = fast_exp(LA[63 * 128 + tid]);
        __syncthreads();
        f32x4 acc[2][8];
#pragma unroll
        for (int x = 0; x < 2; ++x)
#pragma unroll
            for (int y = 0; y < 8; ++y) acc[x][y] = (f32x4){0.f, 0.f, 0.f, 0.f};
#pragma unroll
        for (int s = 0; s < 2; ++s) {
            const int r0 = 32 * s + 4 * quad + (i16 >> 2);
            bf16x8 Af[2];
#pragma unroll
            for (int x = 0; x < 2; ++x) { const LAS unsigned char* p = VV + r0 * S256 + (16 * (2 * wave + x)) * 2 + 8 * (i16 & 3); Af[x] = trfrag(p, p + 16 * S256); }
#pragma unroll
            for (int y = 0; y < 8; ++y) { const LAS unsigned char* p = KL + r0 * S128 + (16 * y) * 2 + 8 * (i16 & 3); const bf16x8 Bf = trfrag(p, p + 16 * S128);
#pragma unroll
                for (int x = 0; x < 2; ++x) acc[x][y] = MFMA16(Af[x], Bf, acc[x][y]); }
        }
#pragma unroll
        for (int x = 0; x < 2; ++x)
#pragma unroll
            for (int y = 0; y < 8; ++y)
#pragma unroll
                for (int jj = 0; jj < 4; ++jj) UT[(size_t)uid * 32768 + (size_t)(16 * (2 * wave + x) + 4 * quad + jj) * 128 + 16 * y + i16] = acc[x][y][jj];
        __syncthreads();
    }
}
DI void phase_gla_g2(const Args& a, int G, int bx) {
    const float* UT = (const float*)(a.ws + GLA_UT); const float* DL = (const float*)(a.ws + GLA_DL); bf16_t* ST = (bf16_t*)(a.ws + GLA_ST);
    const int nthr = G * NT; const int total = 65536 + 1048576;
    for (int it = bx * NT + otid(); it < total; it += nthr) {
        if (it < 65536) {
            const int chain = it >> 13, e4 = it & 8191, dv = e4 >> 5, dk4 = (e4 & 31) * 4, b = chain >> 2, h = chain & 3;
            f32x4 S = {0.f, 0.f, 0.f, 0.f};
#pragma unroll 4
            for (int c = 0; c < 128; ++c) {
                const int uid = ((b * 128 + c) << 2) | h; const size_t base = (size_t)uid * 32768 + dv * 128 + dk4;
                u32x2 w; w.x = pk_bf16(S[0], S[1]); w.y = pk_bf16(S[2], S[3]); *(u32x2*)(ST + base) = w;
                const f32x4 dl = *(const f32x4*)(DL + (size_t)uid * 128 + dk4); const f32x4 uu = *(const f32x4*)(UT + base);
                S = dl * S + uu;
            }
            float* o = a.out + O_GLA_P + (size_t)((b * 4 + h) * 128 + dk4) * 256 + dv;
#pragma unroll
            for (int i = 0; i < 4; ++i) o[i * 256] = S[i];
        } else {
            const int e = it - 65536, chain = e >> 13, e4 = e & 8191, dv = e4 >> 5, dk4 = (e4 & 31) * 4, bs = chain >> 2, h = chain & 3;
            const int uid = ((256 + bs) << 2) | h; const size_t base = (size_t)uid * 32768 + dv * 128 + dk4;
            const size_t so = (size_t)((bs * 4 + h) * 128 + dk4) * 256 + dv;
            f32x4 S;
#pragma unroll
            for (int i = 0; i < 4; ++i) S[i] = a.in[2][so + i * 256];
            u32x2 w; w.x = pk_bf16(S[0], S[1]); w.y = pk_bf16(S[2], S[3]); *(u32x2*)(ST + base) = w;
            const f32x4 dl = *(const f32x4*)(DL + (size_t)uid * 128 + dk4); const f32x4 uu = *(const f32x4*)(UT + base);
            S = dl * S + uu;
#pragma unroll
            for (int i = 0; i < 4; ++i) a.out[O_GLA_S + so + i * 256] = S[i];
        }
    }
}
DI void phase_gla_g3(const Args& a, LAS unsigned char* lds, int G, int bx) {
    const int tid = otid(), lane = tid & 63, wave = tid >> 6, i16 = lane & 15, quad = lane >> 4;
    LAS float* LA = (LAS float*)lds; LAS unsigned char* QE = lds + 32768; LAS unsigned char* KE = QE + 64 * S128; LAS unsigned char* VV = KE + 64 * S128;
    LAS float* XCH = (LAS float*)(VV + 64 * S256);
    const bf16_t* Qg = (const bf16_t*)(a.ws + GLA_Q); const bf16_t* Kg = (const bf16_t*)(a.ws + GLA_K); const bf16_t* Vg = (const bf16_t*)(a.ws + GLA_V);
    const bf16_t* Rg = (const bf16_t*)(a.ws + GLA_R); const float* la_g = (const float*)(a.ws + GLA_LA); const bf16_t* ST = (const bf16_t*)(a.ws + GLA_ST);
    bf16_t* OB = (bf16_t*)(a.ws + WS_OB); const float* onorm = a.in[19];
    const int ib = wave & 3, dh = wave >> 2;
    for (int uid = bx; uid < GLA_UNITS; uid += G) {
        const int cr = uid >> 2, h = uid & 3, row0 = cr * 64;
        gla_load_v(VV, Vg, row0, h, tid);
        gla_load_cumsum(LA, la_g, row0, h, tid);
#pragma unroll
        for (int i = 0; i < 2; ++i) { const int q = tid + i * NT, t = q >> 4, c8 = (q & 15) * 8;
            float qf[8], kf[8]; unpack8(*(const u32x4*)(Qg + (size_t)(row0 + t) * 512 + h * 128 + c8), qf); unpack8(*(const u32x4*)(Kg + (size_t)(row0 + t) * 512 + h * 128 + c8), kf);
#pragma unroll
            for (int e = 0; e < 8; ++e) { const float bb = LA[t * 128 + c8 + e]; qf[e] *= fast_exp(bb); kf[e] *= fast_exp(-bb); }
            *(LAS u32x4*)(QE + t * S128 + c8 * 2) = pack8(qf); *(LAS u32x4*)(KE + t * S128 + c8 * 2) = pack8(kf); }
        __syncthreads();
        bf16x8 Bq[4];
#pragma unroll
        for (int s = 0; s < 4; ++s) Bq[s] = ldfrag_l(QE + (16 * ib + i16) * S128 + (32 * s + 8 * quad) * 2);
        f32x4 at[4];
#pragma unroll
        for (int jb = 0; jb < 4; ++jb) {
            f32x4 c = {0.f, 0.f, 0.f, 0.f};
            if (jb <= ib) {
#pragma unroll
                for (int s = 0; s < 4; ++s) c = MFMA16(ldfrag_l(KE + (16 * jb + i16) * S128 + (32 * s + 8 * quad) * 2), Bq[s], c);
                if (jb == ib) {
#pragma unroll
                    for (int jj = 0; jj < 4; ++jj) if (4 * quad + jj > i16) c[jj] = 0.f;
                }
            }
            at[jb] = c;
        }
        const bf16x8 Pf0 = packfrag(at[0], at[1]), Pf1 = packfrag(at[2], at[3]);
        f32x4 o[8]; float ss = 0.f;
#pragma unroll
        for (int dvt = 0; dvt < 8; ++dvt) {
            const int dvb = 8 * dh + dvt; f32x4 c = {0.f, 0.f, 0.f, 0.f};
            { const LAS unsigned char* p = VV + (4 * quad + (i16 >> 2)) * S256 + (16 * dvb) * 2 + 8 * (i16 & 3);
              c = MFMA16(trfrag(p, p + 16 * S256), Pf0, c);
              if (ib >= 2) c = MFMA16(trfrag(p + 32 * S256, p + 48 * S256), Pf1, c); }
            const bf16_t* sp = ST + (size_t)uid * 32768 + (size_t)(16 * dvb + i16) * 128 + 8 * quad;
#pragma unroll
            for (int s = 0; s < 4; ++s) c = MFMA16(ldfrag_g(sp + 32 * s), Bq[s], c);
            o[dvt] = c; ss += (c[0] * c[0] + c[1] * c[1]) + (c[2] * c[2] + c[3] * c[3]);
        }
        ss += __shfl_xor(ss, 16); ss += __shfl_xor(ss, 32);
        if (quad == 0) XCH[dh * 64 + 16 * ib + i16] = ss;
        __syncthreads();
        const float rstd = rsq((XCH[16 * ib + i16] + XCH[64 + 16 * ib + i16]) * (1.0f / 256.0f) + EPS);
        const int row = row0 + 16 * ib + i16;
#pragma unroll
        for (int dvt = 0; dvt < 8; ++dvt) {
            const int dv0 = 16 * (8 * dh + dvt) + 4 * quad;
            const f32x4 g = *(const f32x4*)(onorm + dv0); const u32x2 rr = *(const u32x2*)(Rg + (size_t)row * 1024 + h * 256 + dv0);
            u32x2 w; w.x = pk_bf16(o[dvt][0] * rstd * g[0] * bf_lo(rr.x), o[dvt][1] * rstd * g[1] * bf_hi(rr.x));
            w.y = pk_bf16(o[dvt][2] * rstd * g[2] * bf_lo(rr.y), o[dvt][3] * rstd * g[3] * bf_hi(rr.y));
            *(u32x2*)(OB + (size_t)row * 1024 + h * 256 + dv0) = w;
        }
        __syncthreads();
    }
}


constexpr int AT_KT = 0, AT_VT = 64 * S128, AT_BIAS = 2 * 64 * S128;
DI void stage_bf16(LAS unsigned char* dst, const bf16_t* src, int tid) {
#pragma unroll
    for (int i = 0; i < 2; ++i) { const int q = tid + i * NT, r = q >> 4, c8 = (q & 15) * 8;
        *(LAS u32x4*)(dst + r * S128 + c8 * 2) = *(const u32x4*)(src + (size_t)r * 1024 + c8); }
}
DI void stage_f32(LAS unsigned char* dst, const float* src, int tid) {
#pragma unroll
    for (int i = 0; i < 2; ++i) { const int q = tid + i * NT, r = q >> 4, c8 = (q & 15) * 8;
        const f32x4 v0 = *(const f32x4*)(src + (size_t)r * 1024 + c8), v1 = *(const f32x4*)(src + (size_t)r * 1024 + c8 + 4);
        u32x4 w; w.x = pk_bf16(v0[0], v0[1]); w.y = pk_bf16(v0[2], v0[3]); w.z = pk_bf16(v1[0], v1[1]); w.w = pk_bf16(v1[2], v1[3]);
        *(LAS u32x4*)(dst + r * S128 + c8 * 2) = w; }
}
DI void qk_tiles(f32x4 (&zt)[4], const LAS unsigned char* KT, const bf16x8 (&Bq)[2], int hh, int i16, int quad) {
#pragma unroll
    for (int jb = 0; jb < 4; ++jb) { f32x4 c = {0.f, 0.f, 0.f, 0.f};
#pragma unroll
        for (int s = 0; s < 2; ++s) c = MFMA16(ldfrag_l(KT + (16 * jb + i16) * S128 + (hh * 64 + 32 * s + 8 * quad) * 2), Bq[s], c);
        zt[jb] = c; }
}
DI void pv_tiles(f32x4 (&o)[4], const LAS unsigned char* VT, const f32x4 (&pt)[4], int hh, int i16, int quad) {
    const bf16x8 P0 = packfrag(pt[0], pt[1]), P1 = packfrag(pt[2], pt[3]);
#pragma unroll
    for (int db = 0; db < 4; ++db) { const LAS unsigned char* p = VT + (4 * quad + (i16 >> 2)) * S128 + (hh * 64 + 16 * db) * 2 + 8 * (i16 & 3);
        o[db] = MFMA16(trfrag(p, p + 16 * S128), P0, o[db]); o[db] = MFMA16(trfrag(p + 32 * S128, p + 48 * S128), P1, o[db]); }
}
DI void phase_band(const Args& a, LAS unsigned char* lds, int G, int bx) {
    const int tid = otid(), lane = tid & 63, wave = __builtin_amdgcn_readfirstlane(tid >> 6), i16 = lane & 15, quad = lane >> 4, hh = wave >> 2, ib = wave & 3;
    LAS unsigned char* KT = lds + AT_KT; LAS unsigned char* VT = lds + AT_VT; LAS float* BIAS = (LAS float*)(lds + AT_BIAS);
    const bf16_t* Qg = (const bf16_t*)(a.ws + AT_Q); const bf16_t* Kg = (const bf16_t*)(a.ws + AT_K); const bf16_t* Vg = (const bf16_t*)(a.ws + AT_V);
    bf16_t* OB = (bf16_t*)(a.ws + WS_OB); const float* rel_bias = a.in[24];
    for (int uid = bx; uid < 2304; uid += G) {
        int hp, qrow0, c = 8, bs = 0, brow0 = 0; const bool samp = uid >= 2048;
        if (!samp) { hp = uid & 7; const int bc = uid >> 3; c = bc & 127; const int b = bc >> 7; brow0 = b * SEQ; qrow0 = brow0 + 64 * c; }
        else { const int u2 = uid - 2048; hp = u2 & 7; bs = u2 >> 3; qrow0 = MP + 64 * bs; }
        __syncthreads();
        for (int q = tid; q < 1026; q += NT) { const int hsel = q >= 513, idx = q - 513 * hsel; BIAS[hsel * 516 + idx] = rel_bias[(2 * hp + hsel) * 513 + idx]; }
        bf16x8 Bq[2];
#pragma unroll
        for (int s = 0; s < 2; ++s) Bq[s] = ldfrag_g(Qg + (size_t)(qrow0 + 16 * ib + i16) * 1024 + (2 * hp + hh) * 64 + 32 * s + 8 * quad);
        float mrun = -INFINITY, lrun = 0.f; f32x4 o[4];
#pragma unroll
        for (int db = 0; db < 4; ++db) o[db] = (f32x4){0.f, 0.f, 0.f, 0.f};
        const int T0 = (!samp && c < 8) ? 8 - c : 0;
        for (int T = T0; T < 9; ++T) {
            __syncthreads();
            if (samp && T < 8) { stage_f32(KT, a.in[3] + ((size_t)bs * 512 + 64 * T) * 1024 + hp * 128, tid); stage_f32(VT, a.in[4] + ((size_t)bs * 512 + 64 * T) * 1024 + hp * 128, tid); }
            else { const size_t kr = samp ? (size_t)qrow0 : (size_t)(brow0 + 64 * (c - 8 + T)); stage_bf16(KT, Kg + kr * 1024 + hp * 128, tid); stage_bf16(VT, Vg + kr * 1024 + hp * 128, tid); }
            __syncthreads();
            f32x4 zt[4]; qk_tiles(zt, KT, Bq, hh, i16, quad);
            float tmax = -INFINITY;
#pragma unroll
            for (int jb = 0; jb < 4; ++jb)
#pragma unroll
                for (int jj = 0; jj < 4; ++jj) { int idx = 768 - 64 * T + (16 * ib + i16) - (16 * jb + 4 * quad + jj); idx = idx < 0 ? 0 : (idx > 512 ? 512 : idx);
                    const float s = zt[jb][jj] + BIAS[hh * 516 + idx]; zt[jb][jj] = s; tmax = fmaxf(tmax, s); }
            tmax = fmaxf(tmax, __shfl_xor(tmax, 16)); tmax = fmaxf(tmax, __shfl_xor(tmax, 32));
            const float mnew = fmaxf(mrun, tmax), sc = fast_exp(mrun - mnew); float psum = 0.f;
#pragma unroll
            for (int jb = 0; jb < 4; ++jb)
#pragma unroll
                for (int jj = 0; jj < 4; ++jj) { const float p = fast_exp(zt[jb][jj] - mnew); zt[jb][jj] = p; psum += p; }
            lrun = lrun * sc + psum; mrun = mnew;
#pragma unroll
            for (int db = 0; db < 4; ++db) o[db] = o[db] * sc;
            pv_tiles(o, VT, zt, hh, i16, quad);
        }
        lrun += __shfl_xor(lrun, 16); lrun += __shfl_xor(lrun, 32);
        const float inv = 1.0f / lrun; const int row = qrow0 + 16 * ib + i16;
#pragma unroll
        for (int db = 0; db < 4; ++db) { u32x2 w; w.x = pk_bf16(o[db][0] * inv, o[db][1] * inv); w.y = pk_bf16(o[db][2] * inv, o[db][3] * inv);
            *(u32x2*)(OB + (size_t)row * 1024 + (2 * hp + hh) * 64 + 16 * db + 4 * quad) = w; }
    }
}
constexpr float SB_STOP = 80.0f;
DI void phase_sb(const Args& a, LAS unsigned char* lds, int G, int bx) {
    const int tid = otid(), lane = tid & 63, wave = __builtin_amdgcn_readfirstlane(tid >> 6), i16 = lane & 15, quad = lane >> 4, hh = wave >> 2, ib = wave & 3;
    LAS unsigned char* KT = lds + AT_KT; LAS unsigned char* VT = lds + AT_VT; LAS unsigned* FL = (LAS unsigned*)(lds + AT_BIAS);
    const bf16_t* Qg = (const bf16_t*)(a.ws + AT_Q); const bf16_t* Kg = (const bf16_t*)(a.ws + AT_K); const bf16_t* Vg = (const bf16_t*)(a.ws + AT_V);
    bf16_t* OB = (bf16_t*)(a.ws + WS_OB);
    for (int uid = bx; uid < 2304; uid += G) {
        int hp, qrow0, ntile, bs = 0, brow0 = 0, qblk = 0; const bool samp = uid >= 2048;
        if (!samp) { hp = uid & 7; const int bq = uid >> 3; qblk = 127 - (bq & 127); const int b = bq >> 7; brow0 = b * SEQ; qrow0 = brow0 + 64 * qblk; ntile = qblk + 1; }
        else { const int u2 = uid - 2048; hp = u2 & 7; bs = u2 >> 3; qrow0 = MP + 64 * bs; ntile = 65; }
        bf16x8 Bq[2];
#pragma unroll
        for (int s = 0; s < 2; ++s) Bq[s] = ldfrag_g(Qg + (size_t)(qrow0 + 16 * ib + i16) * 1024 + (2 * hp + hh) * 64 + 32 * s + 8 * quad);
        float carry = 0.f; f32x4 o[4]; bool wdone = false;
#pragma unroll
        for (int db = 0; db < 4; ++db) o[db] = (f32x4){0.f, 0.f, 0.f, 0.f};
        for (int it = 0; it < ntile; ++it) {
            __syncthreads();
            if (it > 0) { const u32x4 f0 = *(const LAS u32x4*)FL, f1 = *(const LAS u32x4*)(FL + 4); if ((f0.x & f0.y & f0.z & f0.w & f1.x & f1.y & f1.z & f1.w) != 0u) break; }
            if (samp && it > 0) { const size_t r = (size_t)bs * 4096 + 64 * (64 - it); stage_f32(KT, a.in[7] + r * 1024 + hp * 128, tid); stage_f32(VT, a.in[8] + r * 1024 + hp * 128, tid); }
            else { const size_t kr = samp ? (size_t)qrow0 : (size_t)(brow0 + 64 * (qblk - it)); stage_bf16(KT, Kg + kr * 1024 + hp * 128, tid); stage_bf16(VT, Vg + kr * 1024 + hp * 128, tid); }
            __syncthreads();
            if (!wdone) {
                f32x4 zt[4]; qk_tiles(zt, KT, Bq, hh, i16, quad);
                f32x4 sp[4]; float g[4];
#pragma unroll
                for (int jb = 0; jb < 4; ++jb) {
#pragma unroll
                    for (int jj = 0; jj < 4; ++jj) { const bool valid = (it > 0) || (16 * jb + 4 * quad + jj < 16 * ib + i16); sp[jb][jj] = valid ? softplusf_(zt[jb][jj]) : 0.f; if (!valid) zt[jb][jj] = -INFINITY; }
                    sp[jb][2] += sp[jb][3]; sp[jb][1] += sp[jb][2]; sp[jb][0] += sp[jb][1]; g[jb] = sp[jb][0];
                }
                float run = carry;
#pragma unroll
                for (int jb = 3; jb >= 0; --jb) {
                    const float x1 = __shfl_xor(g[jb], 16), x2 = __shfl_xor(g[jb], 32), x3 = __shfl_xor(g[jb], 48);
                    const float above = ((quad ^ 1) > quad ? x1 : 0.f) + ((quad ^ 2) > quad ? x2 : 0.f) + ((quad ^ 3) > quad ? x3 : 0.f);
                    const float off = run + above;
#pragma unroll
                    for (int jj = 0; jj < 4; ++jj) zt[jb][jj] = fast_exp(zt[jb][jj] - (off + sp[jb][jj]));
                    run += (g[jb] + x1) + (x2 + x3);
                }
                carry = run;
                pv_tiles(o, VT, zt, hh, i16, quad);
                wdone = __all(carry > SB_STOP);
            }
            if (lane == 0) FL[wave] = wdone ? 1u : 0u;
        }
        const int row = qrow0 + 16 * ib + i16;
#pragma unroll
        for (int db = 0; db < 4; ++db) { u32x2 w; w.x = pk_bf16(o[db][0], o[db][1]); w.y = pk_bf16(o[db][2], o[db][3]);
            *(u32x2*)(OB + (size_t)row * 1024 + (2 * hp + hh) * 64 + 16 * db + 4 * quad) = w; }
    }
}


constexpr int GDN_UNITS = 288 * 8;
constexpr int RAWS = 784;
constexpr int D1_RAW = 0, D1_MM = 0, D1_TB = 17408, D1_QN = 52736, D1_KN = D1_QN + 64 * S128, D1_VB = D1_KN + 64 * S128, D1_KBG = D1_VB + 64 * S128, D1_SM = D1_KBG + 64 * S128;
static_assert(67 * RAWS <= D1_QN && D1_TB + 64 * S64 <= D1_QN && D1_SM + 1024 <= RING_BYTES, "GDN prep LDS map");
DI void phase_gdn_d1(const Args& a, LAS unsigned char* lds, int G, int bx) {
    const int tid = otid(), lane = tid & 63, wave = __builtin_amdgcn_readfirstlane(tid >> 6), i16 = lane & 15, quad = lane >> 4, ib = wave & 3, half = wave >> 2;
    LAS unsigned char* RAW = lds + D1_RAW; LAS float* MM = (LAS float*)(lds + D1_MM); LAS unsigned char* TB = lds + D1_TB;
    LAS unsigned char* QN = lds + D1_QN; LAS unsigned char* KN = lds + D1_KN; LAS unsigned char* VB = lds + D1_VB; LAS unsigned char* KBG = lds + D1_KBG;
    LAS float* BETA = (LAS float*)(lds + D1_SM); LAS float* GC = BETA + 64; LAS float* RNQ = BETA + 128; LAS float* RNK = BETA + 192;
    const bf16_t* QKV = (const bf16_t*)(a.ws + GDN_QKV); const float* BG = (const float*)(a.ws + GDN_BG); const float* cw = a.in[27];
    bf16_t* QE = (bf16_t*)(a.ws + GDN_QE); bf16_t* WN = (bf16_t*)(a.ws + GDN_WN); bf16_t* KLT = (bf16_t*)(a.ws + GDN_KLT); bf16_t* ATT = (bf16_t*)(a.ws + GDN_ATT);
    float* UT = (float*)(a.ws + GDN_UT); float* DLAST = (float*)(a.ws + GDN_DLAST);
    for (int uid = bx; uid < GDN_UNITS; uid += G) {
        const int cr = uid >> 3, h = uid & 7, row0 = cr * 64; const bool samp = cr >= 256; const int bs = cr - 256; const bool first = !samp && (cr & 127) == 0;
        __syncthreads();
        for (int q = tid; q < 67 * 48; q += NT) { const int r = q / 48, ch = q - r * 48, seg = ch >> 4, c8 = (ch & 15) * 8, col = seg * 1024 + h * 128 + c8;
            u32x4 w = {0u, 0u, 0u, 0u};
            if (r >= 3 || (!samp && !first)) w = *(const u32x4*)(QKV + (size_t)(row0 - 3 + r) * 3072 + col);
            else if (samp) { const float* s = a.in[6] + (size_t)(bs * 3 + r) * 3072 + col; const f32x4 v0 = *(const f32x4*)s, v1 = *(const f32x4*)(s + 4);
                w.x = pk_bf16(v0[0], v0[1]); w.y = pk_bf16(v0[2], v0[3]); w.z = pk_bf16(v1[0], v1[1]); w.w = pk_bf16(v1[2], v1[3]); }
            *(LAS u32x4*)(RAW + r * RAWS + (seg * 128 + c8) * 2) = w; }
        if (tid < 64) { BETA[tid] = BG[(size_t)(row0 + tid) * 16 + h]; float v = BG[(size_t)(row0 + tid) * 16 + 8 + h];
#pragma unroll
            for (int o = 1; o < 64; o <<= 1) { const float u = __shfl_up(v, o); if (lane >= o) v += u; }
            GC[tid] = v; }
        __syncthreads();
        for (int q = tid; q < 64 * 48; q += NT) { const int t = q / 48, ch = q - t * 48, seg = ch >> 4, c8 = (ch & 15) * 8, col = seg * 1024 + h * 128 + c8;
            float y[8] = {0.f, 0.f, 0.f, 0.f, 0.f, 0.f, 0.f, 0.f};
#pragma unroll
            for (int i = 0; i < 4; ++i) { float x[8]; unpack8(*(const LAS u32x4*)(RAW + (t + i) * RAWS + (seg * 128 + c8) * 2), x);
                const f32x4 w0 = *(const f32x4*)(cw + i * 3072 + col), w1 = *(const f32x4*)(cw + i * 3072 + col + 4);
#pragma unroll
                for (int e = 0; e < 4; ++e) { y[e] += x[e] * w0[e]; y[4 + e] += x[4 + e] * w1[e]; } }
            const float sc = seg == 2 ? BETA[t] : 1.0f;
#pragma unroll
            for (int e = 0; e < 8; ++e) y[e] = siluf_(y[e]) * sc;
            LAS unsigned char* dst = seg == 0 ? QN : (seg == 1 ? KN : VB);
            *(LAS u32x4*)(dst + t * S128 + c8 * 2) = pack8(y); }
        __syncthreads();
        if (tid < 128) { const int t = tid & 63, which = tid >> 6; const LAS unsigned char* src = (which ? KN : QN) + t * S128; float ss = 0.f;
#pragma unroll
            for (int c = 0; c < 16; ++c) { float x[8]; unpack8(*(const LAS u32x4*)(src + c * 16), x);
#pragma unroll
                for (int e = 0; e < 8; ++e) ss += x[e] * x[e]; }
            float rn = rsq(ss + EPS); if (which == 0) { rn *= 0.08838834764831845f; RNQ[t] = rn; } else RNK[t] = rn; }
        __syncthreads();
        for (int q = tid; q < 2048; q += NT) { const int which = q >> 10, r = q & 1023, t = r >> 4, c8 = (r & 15) * 8; const float eg = fast_exp(GC[t]);
            if (which == 0) { float x[8]; unpack8(*(const LAS u32x4*)(QN + t * S128 + c8 * 2), x); const float rn = RNQ[t]; float xe[8];
#pragma unroll
                for (int e = 0; e < 8; ++e) { x[e] *= rn; xe[e] = x[e] * eg; }
                *(LAS u32x4*)(QN + t * S128 + c8 * 2) = pack8(x); *(u32x4*)(QE + (size_t)uid * 8192 + t * 128 + c8) = pack8(xe);
            } else { float x[8]; unpack8(*(const LAS u32x4*)(KN + t * S128 + c8 * 2), x); const float rn = RNK[t], be = BETA[t] * eg; float xb[8];
#pragma unroll
                for (int e = 0; e < 8; ++e) { x[e] *= rn; xb[e] = x[e] * be; }
                *(LAS u32x4*)(KN + t * S128 + c8 * 2) = pack8(x); *(LAS u32x4*)(KBG + t * S128 + c8 * 2) = pack8(xb); } }
        __syncthreads();
        if (half == 0) {
            bf16x8 Af[4];
#pragma unroll
            for (int s = 0; s < 4; ++s) Af[s] = ldfrag_l(KN + (16 * ib + i16) * S128 + (32 * s + 8 * quad) * 2);
            for (int jb = 0; jb <= ib; ++jb) { f32x4 c = {0.f, 0.f, 0.f, 0.f};
#pragma unroll
                for (int s = 0; s < 4; ++s) c = MFMA16(Af[s], ldfrag_l(KN + (16 * jb + i16) * S128 + (32 * s + 8 * quad) * 2), c);
                const int j = 16 * jb + i16; const float gj = GC[j];
#pragma unroll
                for (int jj = 0; jj < 4; ++jj) { const int i = 16 * ib + 4 * quad + jj; MM[i * 68 + j] = (j < i) ? BETA[i] * c[jj] * fast_exp(GC[i] - gj) : 0.f; } }
        } else {
            bf16x8 Bf[4];
#pragma unroll
            for (int s = 0; s < 4; ++s) Bf[s] = ldfrag_l(QN + (16 * ib + i16) * S128 + (32 * s + 8 * quad) * 2);
            const int i = 16 * ib + i16; const float gi = GC[i];
            for (int jb = 0; jb < 4; ++jb) { f32x4 c = {0.f, 0.f, 0.f, 0.f};
                if (jb <= ib) {
#pragma unroll
                    for (int s = 0; s < 4; ++s) c = MFMA16(ldfrag_l(KN + (16 * jb + i16) * S128 + (32 * s + 8 * quad) * 2), Bf[s], c);
#pragma unroll
                    for (int jj = 0; jj < 4; ++jj) { const int j = 16 * jb + 4 * quad + jj; c[jj] = (j <= i) ? c[jj] * fast_exp(gi - GC[j]) : 0.f; } }
                u32x2 w; w.x = pk_bf16(c[0], c[1]); w.y = pk_bf16(c[2], c[3]);
                *(u32x2*)(ATT + (size_t)uid * 4096 + i * 64 + 16 * jb + 4 * quad) = w; }
        }
        __syncthreads();
        if (wave == 0) { float tc[64];
#pragma unroll
            for (int i = 0; i < 64; ++i) { float acc = (i == lane) ? 1.0f : 0.0f;
#pragma unroll
                for (int j = 0; j < i; ++j) acc -= MM[i * 68 + j] * tc[j];
                tc[i] = acc; }
#pragma unroll
            for (int i = 0; i < 64; ++i) *(LAS bf16_t*)(TB + i * S64 + lane * 2) = (bf16_t)(pk_bf16(tc[i], 0.f) & 0xffffu); }
        for (int q = tid; q < 1024; q += NT) { const int dk = q >> 3, to = (q & 7) * 8; const float gl = GC[63]; float x[8];
#pragma unroll
            for (int e = 0; e < 8; ++e) x[e] = bf2f(*(const LAS bf16_t*)(KN + (to + e) * S128 + dk * 2)) * fast_exp(gl - GC[to + e]);
            *(u32x4*)(KLT + (size_t)uid * 8192 + dk * 64 + to) = pack8(x); }
        if (tid == 0) DLAST[uid] = fast_exp(GC[63]);
        __syncthreads();
        { bf16x8 Tf[2];
#pragma unroll
          for (int s = 0; s < 2; ++s) Tf[s] = ldfrag_l(TB + (16 * ib + i16) * S64 + (32 * s + 8 * quad) * 2);
          const LAS unsigned char* src = half == 0 ? VB : KBG;
#pragma unroll
          for (int cb = 0; cb < 8; ++cb) { f32x4 c = {0.f, 0.f, 0.f, 0.f};
#pragma unroll
              for (int s = 0; s < 2; ++s) { const LAS unsigned char* p = src + (32 * s + 8 * quad + (i16 >> 2)) * S128 + (16 * cb) * 2 + 8 * (i16 & 3); const bf16x8 X = trfrag(p, p + 4 * S128);
                  c = (half == 0) ? MFMA16(Tf[s], X, c) : MFMA16(X, Tf[s], c); }
              if (half == 0) *(f32x4*)(UT + (size_t)uid * 8192 + (16 * cb + i16) * 64 + 16 * ib + 4 * quad) = c;
              else { u32x2 w; w.x = pk_bf16(-c[0], -c[1]); w.y = pk_bf16(-c[2], -c[3]); *(u32x2*)(WN + (size_t)uid * 8192 + (16 * ib + i16) * 128 + 16 * cb + 4 * quad) = w; } }
        }
    }
}
constexpr int D2_WS = 272, D2_KS = 144, D2_KOFF = 64 * D2_WS, D2_SLOT = D2_KOFF + 128 * D2_KS;
static_assert(3 * D2_SLOT <= RING_BYTES, "D2 ring");
DI void d2_fetch(u32x4 (&r)[4], const bf16_t* WN, const bf16_t* KLT, size_t uid, int tid) {
#pragma unroll
    for (int i = 0; i < 2; ++i) { const int q = tid + i * NT; r[i] = *(const u32x4*)(WN + uid * 8192 + (size_t)q * 8); r[2 + i] = *(const u32x4*)(KLT + uid * 8192 + (size_t)q * 8); }
}
DI void d2_put(LAS unsigned char* slot, const u32x4 (&r)[4], int tid) {
#pragma unroll
    for (int i = 0; i < 2; ++i) { const int q = tid + i * NT;
        *(LAS u32x4*)(slot + (q >> 4) * D2_WS + (q & 15) * 16) = r[i];
        *(LAS u32x4*)(slot + D2_KOFF + (q >> 3) * D2_KS + (q & 7) * 16) = r[2 + i]; }
}
DI bf16x8 ldfrag2_l(const LAS unsigned char* p) { const s16x4 a = *(const LAS s16x4*)p, b = *(const LAS s16x4*)(p + 32); return __builtin_shufflevector(a, b, 0, 1, 2, 3, 4, 5, 6, 7); }
DI void phase_gdn_d2(const Args& a, LAS unsigned char* lds, int G, int bx) {
    const int tid = otid(), lane = tid & 63, wave = __builtin_amdgcn_readfirstlane(tid >> 6), i16 = lane & 15, quad = lane >> 4, dv = 16 * wave + i16;
    const bf16_t* WN = (const bf16_t*)(a.ws + GDN_WN); const bf16_t* KLT = (const bf16_t*)(a.ws + GDN_KLT); const float* UT = (const float*)(a.ws + GDN_UT); const float* DLAST = (const float*)(a.ws + GDN_DLAST);
    bf16_t* STB = (bf16_t*)(a.ws + GDN_STB); bf16_t* VNT = (bf16_t*)(a.ws + GDN_VNT);
    int item, istep;
    if (G > 16) { item = bx < 16 ? bx : 16 + (bx - 16); istep = bx < 16 ? 1 << 20 : G - 16; } else { item = bx; istep = G; }
    for (; item < 16 + 256; item += istep) {
        const bool samp = item >= 16; int b, h, nstep; const float* s0 = nullptr; float* sout;
        if (!samp) { b = item >> 3; h = item & 7; nstep = 128; sout = a.out + O_GDN_P + (size_t)(b * 8 + h) * 16384; }
        else { const int e = item - 16; b = e >> 3; h = e & 7; nstep = 1; s0 = a.in[5] + (size_t)(b * 8 + h) * 16384; sout = a.out + O_GDN_S + (size_t)(b * 8 + h) * 16384; }
        const size_t uid0 = (size_t)(samp ? 256 + b : b * 128) * 8 + h;
        f32x4 S[8];
#pragma unroll
        for (int t = 0; t < 8; ++t)
#pragma unroll
            for (int jj = 0; jj < 4; ++jj) S[t][jj] = s0 ? s0[(size_t)(16 * t + 4 * quad + jj) * 128 + dv] : 0.f;
        __syncthreads();
        { u32x4 r[4]; d2_fetch(r, WN, KLT, uid0, tid); d2_put(lds, r, tid);
          if (nstep > 1) { d2_fetch(r, WN, KLT, uid0 + 8, tid); d2_put(lds + D2_SLOT, r, tid); } }
        u32x4 ra[4];
        if (nstep > 2) d2_fetch(ra, WN, KLT, uid0 + 16, tid);
        f32x4 ucur[4]; float dlc = DLAST[uid0];
#pragma unroll
        for (int tb = 0; tb < 4; ++tb) ucur[tb] = *(const f32x4*)(UT + uid0 * 8192 + (size_t)dv * 64 + 16 * tb + 4 * quad);
        __syncthreads();
        int sl = 0;
        for (int c = 0; c < nstep; ++c) {
            const size_t uid = uid0 + 8 * (size_t)c;
            const bool pf = c + 2 < nstep, pf3 = c + 3 < nstep, pu = c + 1 < nstep;
            u32x4 rb[4]; f32x4 unext[4]; float dln = 0.f;
            if (pf3) d2_fetch(rb, WN, KLT, uid + 24, tid);
            if (pu) { dln = DLAST[uid + 8];
#pragma unroll
                for (int tb = 0; tb < 4; ++tb) unext[tb] = *(const f32x4*)(UT + (uid + 8) * 8192 + (size_t)dv * 64 + 16 * tb + 4 * quad); }
            const LAS unsigned char* slot = lds + sl * D2_SLOT;
            bf16x8 Sf[4];
#pragma unroll
            for (int ks = 0; ks < 4; ++ks) Sf[ks] = packfrag(S[2 * ks], S[2 * ks + 1]);
#pragma unroll
            for (int t = 0; t < 8; ++t) { u32x2 w; w.x = pk_bf16(S[t][0], S[t][1]); w.y = pk_bf16(S[t][2], S[t][3]); *(u32x2*)(STB + uid * 16384 + (size_t)dv * 128 + 16 * t + 4 * quad) = w; }
            f32x4 vn[4];
#pragma unroll
            for (int tb = 0; tb < 4; ++tb) { f32x4 cacc = ucur[tb];
                const LAS unsigned char* wp = slot + (16 * tb + i16) * D2_WS + 8 * quad;
#pragma unroll
                for (int ks = 0; ks < 4; ++ks) cacc = MFMA16(ldfrag2_l(wp + 64 * ks), Sf[ks], cacc);
                vn[tb] = cacc;
                u32x2 w; w.x = pk_bf16(cacc[0], cacc[1]); w.y = pk_bf16(cacc[2], cacc[3]); *(u32x2*)(VNT + uid * 8192 + (size_t)dv * 64 + 16 * tb + 4 * quad) = w; }
            const bf16x8 Vf0 = packfrag(vn[0], vn[1]), Vf1 = packfrag(vn[2], vn[3]);
#pragma unroll
            for (int t = 0; t < 8; ++t) { const LAS unsigned char* kp = slot + D2_KOFF + (16 * t + i16) * D2_KS + 8 * quad;
                f32x4 cacc = S[t] * dlc;
                cacc = MFMA16(ldfrag2_l(kp), Vf0, cacc); cacc = MFMA16(ldfrag2_l(kp + 64), Vf1, cacc);
                S[t] = cacc; }
            if (pf) { const int s2 = sl >= 1 ? sl - 1 : 2; d2_put(lds + s2 * D2_SLOT, ra, tid); }
            if (pf3) {
#pragma unroll
                for (int i = 0; i < 4; ++i) ra[i] = rb[i]; }
            if (pu) { dlc = dln;
#pragma unroll
                for (int tb = 0; tb < 4; ++tb) ucur[tb] = unext[tb]; }
            sl = sl == 2 ? 0 : sl + 1;
            lds_barrier();
        }
#pragma unroll
        for (int t = 0; t < 8; ++t)
#pragma unroll
            for (int jj = 0; jj < 4; ++jj) sout[(size_t)(16 * t + 4 * quad + jj) * 128 + dv] = S[t][jj];
    }
}
DI void phase_gdn_d3(const Args& a, LAS unsigned char* lds, int G, int bx) {
    const int tid = otid(), lane = tid & 63, wave = __builtin_amdgcn_readfirstlane(tid >> 6), i16 = lane & 15, quad = lane >> 4, tb = wave & 3, dh = wave >> 2;
    LAS float* XCH = (LAS float*)lds;
    const bf16_t* QE = (const bf16_t*)(a.ws + GDN_QE); const bf16_t* ATT = (const bf16_t*)(a.ws + GDN_ATT); const bf16_t* STB = (const bf16_t*)(a.ws + GDN_STB); const bf16_t* VNT = (const bf16_t*)(a.ws + GDN_VNT);
    const bf16_t* GG = (const bf16_t*)(a.ws + GDN_GG); bf16_t* OB = (bf16_t*)(a.ws + WS_OB); const float* onorm = a.in[30];
    for (int uid = bx; uid < GDN_UNITS; uid += G) {
        const int cr = uid >> 3, h = uid & 7, row0 = cr * 64;
        bf16x8 Bq[4], Ba[2];
#pragma unroll
        for (int s = 0; s < 4; ++s) Bq[s] = ldfrag_g(QE + (size_t)uid * 8192 + (16 * tb + i16) * 128 + 32 * s + 8 * quad);
#pragma unroll
        for (int s = 0; s < 2; ++s) Ba[s] = ldfrag_g(ATT + (size_t)uid * 4096 + (16 * tb + i16) * 64 + 32 * s + 8 * quad);
        f32x4 o[4]; float ss = 0.f;
#pragma unroll
        for (int dvt = 0; dvt < 4; ++dvt) { const int dvr = 64 * dh + 16 * dvt + i16; f32x4 c = {0.f, 0.f, 0.f, 0.f};
#pragma unroll
            for (int s = 0; s < 4; ++s) c = MFMA16(ldfrag_g(STB + (size_t)uid * 16384 + dvr * 128 + 32 * s + 8 * quad), Bq[s], c);
#pragma unroll
            for (int s = 0; s < 2; ++s) c = MFMA16(ldfrag_g(VNT + (size_t)uid * 8192 + dvr * 64 + 32 * s + 8 * quad), Ba[s], c);
            o[dvt] = c; ss += (c[0] * c[0] + c[1] * c[1]) + (c[2] * c[2] + c[3] * c[3]); }
        ss += __shfl_xor(ss, 16); ss += __shfl_xor(ss, 32);
        __syncthreads();
        if (quad == 0) XCH[dh * 64 + 16 * tb + i16] = ss;
        __syncthreads();
        const float rstd = rsq((XCH[16 * tb + i16] + XCH[64 + 16 * tb + i16]) * (1.0f / 128.0f) + EPS);
        const int row = row0 + 16 * tb + i16;
#pragma unroll
        for (int dvt = 0; dvt < 4; ++dvt) { const int dv0 = 64 * dh + 16 * dvt + 4 * quad;
            const f32x4 g = *(const f32x4*)(onorm + dv0); const u32x2 rr = *(const u32x2*)(GG + (size_t)row * 1024 + h * 128 + dv0);
            u32x2 w; w.x = pk_bf16(o[dvt][0] * rstd * g[0] * bf_lo(rr.x), o[dvt][1] * rstd * g[1] * bf_hi(rr.x));
            w.y = pk_bf16(o[dvt][2] * rstd * g[2] * bf_lo(rr.y), o[dvt][3] * rstd * g[3] * bf_hi(rr.y));
            *(u32x2*)(OB + (size_t)row * 1024 + h * 128 + dv0) = w; }
    }
}


#ifndef MK_N_LAUNCHES
#define MK_N_LAUNCHES 1
#endif
constexpr int PH_END = 1 + 16 * 3 + 9;
DI const bf16_t* wffn(const Args& a, int l, int k) { const size_t off = k == 0 ? 0 : (k == 1 ? (size_t)2 * FF * D : (k == 2 ? (size_t)3 * FF * D : (size_t)5 * FF * D)); return (const bf16_t*)(a.ws + WS_WFFN + (size_t)l * SZ_WFFN_L) + off; }
DI float* ssq_arr(const Args& a, int i) { return (float*)(a.ws + WS_SSQ) + (size_t)i * M * 16; }


enum { K_PRO = 0, K_UP1, K_DN1, K_UP2, K_DN2, K_OUT, K_GLA_IN, K_G1, K_G2, K_G3, K_BAND_IN, K_BAND, K_GDN_IN, K_D1, K_D2, K_D3, K_SB_IN, K_SB, K_NKIND };
template <int KIND, bool REP = false> DI void run_phase(const Args& a, LAS unsigned char* lds, int G, int bx, int l) {
    float* X = a.out; bf16_t* XB = (bf16_t*)(a.ws + WS_XB); bf16_t* ACT = (bf16_t*)(a.ws + WS_ACT); bf16_t* OB = (bf16_t*)(a.ws + WS_OB);
    if constexpr (KIND == K_PRO) phase_prologue(a, lds, G, bx);
    if constexpr (KIND == K_UP1 || KIND == K_UP2) { pg8::Gemm g{XB, wffn(a, l, KIND == K_UP1 ? 0 : 2), M, 2 * FF, D}; pg8::StaticOrder S; S.init(M, 2 * FF, G, bx);
        EpiSwiglu E{ACT, ssq_arr(a, 3 * l + (KIND == K_UP1 ? 0 : 2))}; pg8::gemm_phase<EpiSwiglu, pg8::StaticOrder, true, true>(lds, g, S, E); }
    if constexpr (KIND == K_DN1 || KIND == K_DN2) { pg8::Gemm g{ACT, wffn(a, l, KIND == K_DN1 ? 1 : 3), M, D, FF}; pg8::StaticOrder S; S.init(M, D, G, bx);
        EpiResid E{X, XB, ssq_arr(a, 3 * l + (KIND == K_DN1 ? 1 : 3)), REP ? 0.0f : 0.5f}; pg8::gemm_phase<EpiResid, pg8::StaticOrder, true, true>(lds, g, S, E); }
    if constexpr (KIND == K_OUT) { const size_t wo = l == 0 ? WS_WGLA_OUT : (l == 1 ? WS_WBAND_OUT : (l == 2 ? WS_WGDN_OUT : WS_WSB_OUT));
        pg8::Gemm g{OB, (const bf16_t*)(a.ws + wo), M, D, D}; pg8::StaticOrder S; S.init(M, D, G, bx);
        EpiResid E{X, XB, ssq_arr(a, 3 * l + 2), REP ? 0.0f : 1.0f}; pg8::gemm_phase<EpiResid, pg8::StaticOrder, true, true>(lds, g, S, E); }
    if constexpr (KIND == K_GLA_IN) { pg8::Gemm g{XB, (const bf16_t*)(a.ws + WS_WGLA_IN), M, 3584, D}; pg8::StaticOrder S; S.init(M, 3584, G, bx);
        EpiGlaIn E{ssq_arr(a, 1), (bf16_t*)(a.ws + GLA_Q), (bf16_t*)(a.ws + GLA_K), (bf16_t*)(a.ws + GLA_V), (bf16_t*)(a.ws + GLA_R), (float*)(a.ws + GLA_LA), a.in[18]};
        pg8::gemm_phase<EpiGlaIn, pg8::StaticOrder, true, true>(lds, g, S, E); }
    if constexpr (KIND == K_G1) phase_gla_g1(a, lds, G, bx);
    if constexpr (KIND == K_G2) phase_gla_g2(a, G, bx);
    if constexpr (KIND == K_G3) phase_gla_g3(a, lds, G, bx);
    if constexpr (KIND == K_BAND_IN) { pg8::Gemm g{XB, (const bf16_t*)(a.ws + WS_WBAND_IN), M, 3072, D}; pg8::StaticOrder S; S.init(M, 3072, G, bx);
        EpiBandIn E{ssq_arr(a, 4), (bf16_t*)(a.ws + AT_Q), (const float*)(a.ws + WS_GNB), a.out};
        pg8::gemm_phase<EpiBandIn, pg8::StaticOrder, true, true>(lds, g, S, E); }
    if constexpr (KIND == K_BAND) phase_band(a, lds, G, bx);
    if constexpr (KIND == K_GDN_IN) { pg8::Gemm g{XB, (const bf16_t*)(a.ws + WS_WGDN_IN), M, 4352, D}; pg8::StaticOrder S; S.init(M, 4352, G, bx);
        EpiGdnIn E{ssq_arr(a, 7), (bf16_t*)(a.ws + GDN_QKV), (bf16_t*)(a.ws + GDN_GG), (float*)(a.ws + GDN_BG), a.in[28], a.in[29], a.out + O_GDNC_P, a.out + O_GDNC_S};
        pg8::gemm_phase<EpiGdnIn, pg8::StaticOrder, true, true>(lds, g, S, E); }
    if constexpr (KIND == K_D1) phase_gdn_d1(a, lds, G, bx);
    if constexpr (KIND == K_D2) phase_gdn_d2(a, lds, G, bx);
    if constexpr (KIND == K_D3) phase_gdn_d3(a, lds, G, bx);
    if constexpr (KIND == K_SB_IN) { pg8::Gemm g{XB, (const bf16_t*)(a.ws + WS_WSB_IN), M, 3072, D}; pg8::StaticOrder S; S.init(M, 3072, G, bx);
        EpiSbIn E{ssq_arr(a, 10), (bf16_t*)(a.ws + AT_Q), a.out + O_SBK_P};
        pg8::gemm_phase<EpiSbIn, pg8::StaticOrder, true, true>(lds, g, S, E); }
    if constexpr (KIND == K_SB) phase_sb(a, lds, G, bx);
}
#if MK_N_LAUNCHES != 1
template <int KIND> __global__ void __launch_bounds__(NT, 2) k_phase(KArgs ka, int l) {
    extern __shared__ __attribute__((aligned(16))) unsigned char lds_raw[];
    LAS unsigned char* lds = (LAS unsigned char*)lds_raw;
    store_args(ka, lds); __syncthreads();
    const Args a = load_args(lds);
    run_phase<KIND>(a, lds, gridDim.x, blockIdx.x, l);
}
#else
__global__ void __launch_bounds__(NT, 2) mega(KArgs ka) {
    extern __shared__ __attribute__((aligned(16))) unsigned char lds_raw[];
    LAS unsigned char* lds = (LAS unsigned char*)lds_raw;
    const int tid = threadIdx.x, G = gridDim.x, bx = blockIdx.x;
    for (int u = tid; u < (LDS_BYTES - RING_BYTES) / 4; u += NT) ((LAS unsigned*)(lds + RING_BYTES))[u] = 0u;
    __syncthreads();
    store_args(ka, lds);
    __syncthreads();
    const XcdBarrier bar = xcd_barrier_post((unsigned*)(load_args(lds).ws + WS_CTL) + CW_BAR, (volatile LAS unsigned*)(lds + MISC_OFF) + 8);
#ifndef PROBE_MASK
#define PROBE_MASK 0u
#endif
#define PH(KIND, l) do { { const Args a = load_args(lds); run_phase<KIND>(a, lds, G, bx, l); } xcd_barrier(bar); \
    if ((PROBE_MASK >> KIND) & 1u) { { const Args a = load_args(lds); run_phase<KIND, true>(a, lds, G, bx, l); } xcd_barrier(bar); } } while (0)
    PH(K_PRO, 0);
#define LAYER_HEAD(l) PH(K_UP1, l); PH(K_DN1, l);
#define LAYER_TAIL(l) PH(K_OUT, l); PH(K_UP2, l); { const Args a = load_args(lds); run_phase<K_DN2>(a, lds, G, bx, l); } if ((PROBE_MASK >> K_DN2) & 1u) { xcd_barrier(bar); const Args a = load_args(lds); run_phase<K_DN2, true>(a, lds, G, bx, l); }
    LAYER_HEAD(0) PH(K_GLA_IN, 0); PH(K_G1, 0); PH(K_G2, 0); PH(K_G3, 0); LAYER_TAIL(0) xcd_barrier(bar);
    LAYER_HEAD(1) PH(K_BAND_IN, 1); PH(K_BAND, 1); LAYER_TAIL(1) xcd_barrier(bar);
    LAYER_HEAD(2) PH(K_GDN_IN, 2); PH(K_D1, 2); PH(K_D2, 2); PH(K_D3, 2); LAYER_TAIL(2) xcd_barrier(bar);
    LAYER_HEAD(3) PH(K_SB_IN, 3); PH(K_SB, 3); LAYER_TAIL(3)
#undef LAYER_HEAD
#undef LAYER_TAIL
#undef PH
}
#endif

#if MK_N_LAUNCHES != 1
template <int KIND> static void launch_kind(const KArgs& a, int l, int grid, hipStream_t stream) {
    static bool attr_done = false;
    if (!attr_done) { (void)hipFuncSetAttribute((const void*)k_phase<KIND>, hipFuncAttributeMaxDynamicSharedMemorySize, LDS_BYTES); attr_done = true; }
    hipLaunchKernelGGL(k_phase<KIND>, dim3(grid), dim3(NT), LDS_BYTES, stream, a, l);
}
#endif
extern "C" void kernel_launch(void* const* d_in, const int* in_sizes, int n_in, void* d_out, int out_size, void* d_ws, size_t ws_size, hipStream_t stream) {
    static int grid = 0;
    if (grid == 0) {
        if (n_in != 34 || (size_t)out_size != O_END || ws_size < WS_END) { fprintf(stderr, "kernel_launch: unexpected shapes: n_in %d out %d ws %zu (need %zu)\n", n_in, out_size, ws_size, (size_t)WS_END); grid = -1; return; }
        int dev = 0, cus = 0;
        if (hipGetDevice(&dev) != hipSuccess || hipDeviceGetAttribute(&cus, hipDeviceAttributeMultiprocessorCount, dev) != hipSuccess) { grid = -1; return; }
#if MK_N_LAUNCHES == 1
        int per_cu = 0;
        if (hipFuncSetAttribute((const void*)mega, hipFuncAttributeMaxDynamicSharedMemorySize, LDS_BYTES) != hipSuccess) { fprintf(stderr, "kernel_launch: hipFuncSetAttribute failed\n"); grid = -1; return; }
        if (hipOccupancyMaxActiveBlocksPerMultiprocessor(&per_cu, (const void*)mega, NT, LDS_BYTES) != hipSuccess || per_cu < 1) fprintf(stderr, "kernel_launch: occupancy query reports %d\n", per_cu);
        (void)hipGetLastError();
#endif
        grid = cus;
    }
    if (grid < 0) return;
    if (hipMemsetAsync((char*)d_ws + WS_CTL, 0, CTL_ZERO_BYTES, stream) != hipSuccess) return;
    KArgs a{};
    for (int i = 0; i < 34; ++i) a.in[i] = (const float*)d_in[i];
    a.out = (float*)d_out; a.ws = (unsigned char*)d_ws;
#if MK_N_LAUNCHES == 1
    hipLaunchKernelGGL(mega, dim3(grid), dim3(NT), LDS_BYTES, stream, a);
#else
    launch_kind<K_PRO>(a, 0, grid, stream);
    for (int l = 0; l < 4; ++l) {
        launch_kind<K_UP1>(a, l, grid, stream); launch_kind<K_DN1>(a, l, grid, stream);
        if (l == 0) { launch_kind<K_GLA_IN>(a, l, grid, stream); launch_kind<K_G1>(a, l, grid, stream); launch_kind<K_G2>(a, l, grid, stream); launch_kind<K_G3>(a, l, grid, stream); }
        else if (l == 1) { launch_kind<K_BAND_IN>(a, l, grid, stream); launch_kind<K_BAND>(a, l, grid, stream); }
        else if (l == 2) { launch_kind<K_GDN_IN>(a, l, grid, stream); launch_kind<K_D1>(a, l, grid, stream); launch_kind<K_D2>(a, l, grid, stream); launch_kind<K_D3>(a, l, grid, stream); }
        else { launch_kind<K_SB_IN>(a, l, grid, stream); launch_kind<K_SB>(a, l, grid, stream); }
        launch_kind<K_OUT>(a, l, grid, stream); launch_kind<K_UP2>(a, l, grid, stream); launch_kind<K_DN2>(a, l, grid, stream);
    }
#endif
}
```
